# Optimizing an MI355X kernel written in HIP

```python
import math
import jax
import jax.numpy as jnp
from jax import lax
import numpy as np

D_MODEL = 1024
BATCH = 8
SEQ = 2048
DEPTH = 2

GRID_W = 64
CTX_LEN = 256
MIX_WIDTH = D_MODEL
N_BRANCH = 3
HEAD_DIM = 128
ATT_HEADS = MIX_WIDTH // HEAD_DIM
ATT_KV_HEADS = ATT_HEADS // 4
ATT_WIDTH = ATT_HEADS * HEAD_DIM
KV_WIDTH = ATT_KV_HEADS * HEAD_DIM
Q_BLOCK = 128
ROPE_THETA = 10000.0
HG_KDIM = 128
HG_HEADS = MIX_WIDTH // HG_KDIM
HG_VDIM = MIX_WIDTH // HG_HEADS
HG_KWIDTH = HG_HEADS * HG_KDIM
HG_VWIDTH = HG_HEADS * HG_VDIM
HG_CHUNK = 64
HG_MIN_F = 1e-6
HY_WIDTH = MIX_WIDTH
HY_ORDER = 2
HY_SHORT = 3
HY_BANDS = 16
HY_EMB = 1 + 2 * HY_BANDS
HY_FILTER_HIDDEN = 64
HY_FAST_DECAY = 0.3
HY_SLOW_DECAY = 1.5
HY_TARGET = 1e-2
HY_MIN_DECAY = math.log(HY_TARGET) / HY_SLOW_DECAY
HY_MAX_DECAY = math.log(HY_TARGET) / HY_FAST_DECAY
D_FF = 4 * D_MODEL
EPS = 1e-6
F32 = jnp.float32
IN_SIZES = (ATT_WIDTH, KV_WIDTH, KV_WIDTH,
            HG_KWIDTH, HG_KWIDTH, HG_KWIDTH, HG_VWIDTH, HG_VWIDTH,
            (HY_ORDER + 1) * HY_WIDTH,
            N_BRANCH * D_MODEL)
IN_TOTAL = (ATT_WIDTH + 2 * KV_WIDTH + 3 * HG_KWIDTH + 2 * HG_VWIDTH
            + (HY_ORDER + 1) * HY_WIDTH + N_BRANCH * D_MODEL)

kernel_name = "hybrid_flow_backbone"


def rms_norm(x, g):
    xf = x.astype(F32)
    y = xf * lax.rsqrt(jnp.mean(xf * xf, axis=-1, keepdims=True) + EPS)
    return (y * g.astype(F32)).astype(x.dtype)


def adaln_modulation(cvec, w, b):
    m = jnp.einsum('...d,de->...e', jax.nn.silu(cvec), w) + b
    return jnp.split(m, 6, axis=-1)


def split_in(z):
    out, start = [], 0
    for size in IN_SIZES:
        out.append(z[..., start:start + size])
        start += size
    return out


def heads(t, n):
    b, l, _ = t.shape
    return t.reshape(b, l, n, -1).transpose(0, 2, 1, 3)


def axial_rope_tables(row, col):
    half = HEAD_DIM // 2
    inv = ROPE_THETA ** (-jnp.arange(0, half, 2, dtype=F32) / half)
    ar = row.astype(F32)[:, None] * inv
    ac = col.astype(F32)[:, None] * inv
    ang = jnp.concatenate([ar, ar, ac, ac], axis=-1)
    return jnp.cos(ang), jnp.sin(ang)


def apply_axial_rope(x, cos, sin):
    def rot_half(u):
        u1, u2 = jnp.split(u, 2, axis=-1)
        return jnp.concatenate([-u2, u1], axis=-1)
    xr, xc = jnp.split(x, 2, axis=-1)
    rx = jnp.concatenate([rot_half(xr), rot_half(xc)], axis=-1)
    return (x * cos + rx * sin).astype(x.dtype)


def attend(qb, keys, vals):
    s = jnp.einsum('bkgqd,bksd->bkgqs', qb, keys).astype(F32) * (HEAD_DIM ** -0.5)
    p = jax.nn.softmax(s, axis=-1).astype(vals.dtype)
    return jnp.einsum('bkgqs,bksd->bkgqd', p, vals)


def attention_mixer(q_l, k_l, v_l, q_c, k_c, v_c, gq, gk, cos, sin, need_ctx):
    b, n_lat, _ = q_l.shape
    grp = ATT_HEADS // ATT_KV_HEADS
    ql = apply_axial_rope(rms_norm(heads(q_l, ATT_HEADS), gq), cos, sin)
    kl = apply_axial_rope(rms_norm(heads(k_l, ATT_KV_HEADS), gk), cos, sin)
    kc = rms_norm(heads(k_c, ATT_KV_HEADS), gk)
    vl = heads(v_l, ATT_KV_HEADS)
    vc = heads(v_c, ATT_KV_HEADS)
    keys = jnp.concatenate([kl, kc], axis=2)
    vals = jnp.concatenate([vl, vc], axis=2)
    nblk = n_lat // Q_BLOCK
    qb = ql.reshape(b, ATT_KV_HEADS, grp, nblk, Q_BLOCK, HEAD_DIM).transpose(3, 0, 1, 2, 4, 5)
    ol = lax.map(lambda blk: attend(blk, keys, vals), qb)
    out_l = ol.transpose(1, 0, 4, 2, 3, 5).reshape(b, n_lat, ATT_WIDTH)
    out_c = None
    if need_ctx:
        n_ctx = q_c.shape[1]
        qc = rms_norm(heads(q_c, ATT_HEADS), gq).reshape(b, ATT_KV_HEADS, grp, n_ctx, HEAD_DIM)
        out_c = attend(qc, kc, vc).transpose(0, 3, 1, 2, 4).reshape(b, n_ctx, ATT_WIDTH)
    return out_l, out_c


def hgrn2_chunk_scan(q, k, v, log_f, s0):
    b, h, n, kd = q.shape
    vd = v.shape[-1]
    nc = n // HG_CHUNK
    resh = lambda a: a.reshape(b, h, nc, HG_CHUNK, a.shape[-1]).transpose(2, 0, 1, 3, 4)
    tri = jnp.tril(jnp.ones((HG_CHUNK, HG_CHUNK), dtype=bool))[:, :, None]

    def step(state, inp):
        qb, kb, vb, fb = inp
        cum = jnp.cumsum(fb, axis=2)
        o_inter = jnp.einsum('bhck,bhkv->bhcv', qb * jnp.exp(cum), state)
        diff = cum[:, :, :, None, :] - cum[:, :, None, :, :]
        decay = jnp.where(tri, jnp.exp(jnp.where(tri, diff, 0.0)), 0.0)
        scores = jnp.einsum('bhtk,bhsk,bhtsk->bhts', qb, kb, decay)
        o = o_inter + jnp.einsum('bhts,bhsv->bhtv', scores, vb)
        last = cum[:, :, -1:, :]
        new_state = state * jnp.exp(last[:, :, 0, :, None]) + jnp.einsum(
            'bhsk,bhsv->bhkv', kb * jnp.exp(last - cum), vb)
        return new_state, o

    s_fin, oc = lax.scan(step, s0, (resh(q), resh(k), resh(v), resh(log_f)))
    return oc.transpose(1, 2, 0, 3, 4).reshape(b, h, n, vd), s_fin


def hgrn2_direction(q, i, z, lb, s0):
    f = lb + (1.0 - lb) * jax.nn.sigmoid(z)
    log_f = jnp.log(jnp.maximum(f, HG_MIN_F))
    k = (1.0 - lb) * jax.nn.sigmoid(-z)
    return hgrn2_chunk_scan(q, k, i, log_f, s0)


def hgrn2_readout(o, g, g_norm):
    b, h, n, vd = o.shape
    o = rms_norm(o, g_norm).transpose(0, 2, 1, 3).reshape(b, n, h * vd)
    return (o * jax.nn.silu(g.astype(F32))).astype(g.dtype)


def hgrn2_mixer(q_l, zf_l, zb_l, i_l, g_l, q_c, zf_c, zb_c, i_c, g_c, lb, g_norm, need_ctx):
    to_heads = lambda t: heads(t, HG_HEADS).astype(F32)
    lb_f = lb[0].reshape(HG_HEADS, 1, HG_KDIM)
    lb_b = lb[1].reshape(HG_HEADS, 1, HG_KDIM)
    rev = lambda t: jnp.flip(t, axis=2)
    s0 = jnp.zeros((q_l.shape[0], HG_HEADS, HG_KDIM, HG_VDIM), F32)
    qC, fC, bC, iC = [to_heads(t) for t in (q_c, zf_c, zb_c, i_c)]
    qL, fL, bL, iL = [to_heads(t) for t in (q_l, zf_l, zb_l, i_l)]
    o_cf, s_cf = hgrn2_direction(qC, iC, fC, lb_f, s0)
    o_cb, s_cb = hgrn2_direction(rev(qC), rev(iC), rev(bC), lb_b, s0)
    o_lf, _ = hgrn2_direction(qL, iL, fL, lb_f, s_cf)
    o_lb, _ = hgrn2_direction(rev(qL), rev(iL), rev(bL), lb_b, s_cb)
    out_l = hgrn2_readout(o_lf + rev(o_lb), g_l, g_norm)
    out_c = hgrn2_readout(o_cf + rev(o_cb), g_c, g_norm) if need_ctx else None
    return out_l, out_c


def hyena_filters(n, w1, b1, w2, b2, w3, freq):
    t = jnp.linspace(0.0, 1.0, n, dtype=F32)[:, None]
    w = (2.0 * math.pi / n) * jnp.arange(n, dtype=F32)[:, None]
    f = jnp.linspace(1e-4, HY_BANDS - 1, HY_BANDS, dtype=F32)[None, :]
    z = jnp.concatenate([t, jnp.cos(f * w), -jnp.sin(f * w)], axis=-1)
    h = jnp.sin(freq[0] * (z @ w1 + b1))
    h = jnp.sin(freq[1] * (h @ w2 + b2))
    h = (h @ w3).astype(F32).reshape(n, HY_ORDER, 2, HY_WIDTH)
    deltas = jnp.abs(jnp.linspace(HY_MIN_DECAY, HY_MAX_DECAY, HY_WIDTH, dtype=F32))
    h = h * jnp.exp(-t * deltas)[:, None, None, :]
    fwd, bwd = h[:, :, 0], h[:, :, 1]
    filt2 = jnp.concatenate([fwd, jnp.zeros_like(fwd[:1]), bwd[:0:-1]], axis=0)
    return filt2 / (jnp.sum(jnp.abs(filt2), axis=0, keepdims=True) + EPS)


def short_conv(u, w, b):
    n = u.shape[1]
    up = jnp.pad(u, ((0, 0), (1, 1), (0, 0)))
    return up[:, :n] * w[0] + up[:, 1:n + 1] * w[1] + up[:, 2:] * w[2] + b


def hyena_mixer(u, sw, sb, filt2, bias):
    u = short_conv(u, sw, sb).astype(F32)
    x1, x2, v = jnp.split(u, 3, axis=-1)
    n = u.shape[1]
    filt_f = jnp.fft.rfft(filt2, axis=0)
    z = v
    for o, gate in enumerate((x1, x2)):
        zf = jnp.fft.rfft(z, n=2 * n, axis=1)
        zc = jnp.fft.irfft(zf * filt_f[None, :, o], n=2 * n, axis=1)[:, :n]
        z = gate * (zc + z * bias[o].astype(F32))
    return z


def merge_branches(att, hg, hy, gates, wb):
    ga, gh, gy = jnp.split(jax.nn.sigmoid(gates.astype(F32)).astype(gates.dtype), N_BRANCH, axis=-1)
    return ga * (att @ wb[0]) + gh * (hg @ wb[1]) + gy * (hy @ wb[2])


def sq_relu_mlp(h, w1, w2):
    return jnp.square(jax.nn.relu(h @ w1)) @ w2


def setup_inputs(seed: int = 0) -> dict:
    key = jax.random.key(seed)
    ks = jax.random.split(key, 32)
    nrm = lambda k, shape, s: jax.random.normal(k, shape, F32) * s
    return {
        'x': nrm(ks[0], (BATCH, SEQ, D_MODEL), 1.0),
        'c': nrm(ks[1], (BATCH, D_MODEL), 1.0),
        'ctx': nrm(ks[2], (BATCH, CTX_LEN, D_MODEL), 1.0),
        'c_ctx': nrm(ks[3], (D_MODEL,), 1.0),
        'ada_w': nrm(ks[4], (DEPTH, D_MODEL, 6 * D_MODEL), 0.5 * D_MODEL ** -0.5),
        'ada_b': nrm(ks[5], (DEPTH, 6 * D_MODEL), 0.02),
        'norm1_g': 1.0 + nrm(ks[6], (DEPTH, D_MODEL), 0.02),
        'norm2_g': 1.0 + nrm(ks[7], (DEPTH, D_MODEL), 0.02),
        'w_in': nrm(ks[8], (DEPTH, D_MODEL, IN_TOTAL), D_MODEL ** -0.5),
        'q_norm_g': 1.0 + nrm(ks[9], (DEPTH, HEAD_DIM), 0.02),
        'k_norm_g': 1.0 + nrm(ks[10], (DEPTH, HEAD_DIM), 0.02),
        'hg_lb_raw': nrm(ks[11], (DEPTH, 2, HG_KWIDTH), 0.1),
        'hg_norm_g': 1.0 + nrm(ks[12], (DEPTH, HG_VDIM), 0.02),
        'hy_short_w': nrm(ks[13], (DEPTH, HY_SHORT, (HY_ORDER + 1) * HY_WIDTH), HY_SHORT ** -0.5),
        'hy_short_b': nrm(ks[14], (DEPTH, (HY_ORDER + 1) * HY_WIDTH), 0.02),
        'hy_filt_w1': nrm(ks[15], (DEPTH, HY_EMB, HY_FILTER_HIDDEN), HY_EMB ** -0.5),
        'hy_filt_b1': nrm(ks[16], (DEPTH, HY_FILTER_HIDDEN), 0.02),
        'hy_filt_w2': nrm(ks[17], (DEPTH, HY_FILTER_HIDDEN, HY_FILTER_HIDDEN), HY_FILTER_HIDDEN ** -0.5),
        'hy_filt_b2': nrm(ks[18], (DEPTH, HY_FILTER_HIDDEN), 0.02),
        'hy_filt_w3': nrm(ks[19], (DEPTH, HY_FILTER_HIDDEN, HY_ORDER * 2 * HY_WIDTH), HY_FILTER_HIDDEN ** -0.5),
        'hy_freq': 1.0 + nrm(ks[20], (DEPTH, 2, HY_FILTER_HIDDEN), 0.02),
        'hy_bias': nrm(ks[21], (DEPTH, HY_ORDER, HY_WIDTH), 0.1),
        'w_branch': nrm(ks[22], (DEPTH, N_BRANCH, MIX_WIDTH, D_MODEL), MIX_WIDTH ** -0.5),
        'w_out': nrm(ks[23], (DEPTH, D_MODEL, D_MODEL), D_MODEL ** -0.5),
        'w_mlp1': nrm(ks[24], (DEPTH, D_MODEL, D_FF), D_MODEL ** -0.5),
        'w_mlp2': nrm(ks[25], (DEPTH, D_FF, D_MODEL), D_FF ** -0.5),
    }


def reference(x, c, ctx, c_ctx, ada_w, ada_b, norm1_g, norm2_g, w_in, q_norm_g, k_norm_g,
              hg_lb_raw, hg_norm_g, hy_short_w, hy_short_b, hy_filt_w1, hy_filt_b1,
              hy_filt_w2, hy_filt_b2, hy_filt_w3, hy_freq, hy_bias, w_branch, w_out,
              w_mlp1, w_mlp2):
    n_lat = x.shape[1]
    n_ctx = ctx.shape[1]
    rows = n_lat // GRID_W
    row = jnp.repeat(jnp.arange(rows, dtype=jnp.int32), GRID_W)
    col = jnp.tile(jnp.arange(GRID_W, dtype=jnp.int32), rows)
    cos, sin = axial_rope_tables(row, col)
    sm = jax.nn.softmax(hg_lb_raw.astype(F32), axis=0)
    lower = jnp.cumsum(sm, axis=0) - sm[0:1]

    xl, xc = x, ctx
    for l in range(DEPTH):
        need_ctx = l < DEPTH - 1
        sh1, sc1, ga1, sh2, sc2, ga2 = [m[:, None, :] for m in adaln_modulation(c, ada_w[l], ada_b[l])]
        csh1, csc1, cga1, csh2, csc2, cga2 = adaln_modulation(c_ctx, ada_w[l], ada_b[l])

        hl = rms_norm(xl, norm1_g[l]) * (1.0 + sc1) + sh1
        hc = rms_norm(xc, norm1_g[l]) * (1.0 + csc1) + csh1
        ql, kl, vl, hql, hfl, hbl, hil, hgl, hyl, gtl = split_in(hl @ w_in[l])
        qc, kc, vc, hqc, hfc, hbc, hic, hgc, hyc, gtc = split_in(hc @ w_in[l])

        att_l, att_c = attention_mixer(ql, kl, vl, qc, kc, vc, q_norm_g[l], k_norm_g[l], cos, sin, need_ctx)
        hg_l, hg_c = hgrn2_mixer(hql, hfl, hbl, hil, hgl, hqc, hfc, hbc, hic, hgc,
                                 lower[l], hg_norm_g[l], need_ctx)
        filt_l = hyena_filters(n_lat, hy_filt_w1[l], hy_filt_b1[l], hy_filt_w2[l], hy_filt_b2[l],
                               hy_filt_w3[l], hy_freq[l])
        hy_l = hyena_mixer(hyl, hy_short_w[l], hy_short_b[l], filt_l, hy_bias[l]).astype(xl.dtype)
        xl = xl + ga1 * (merge_branches(att_l, hg_l, hy_l, gtl, w_branch[l]) @ w_out[l])
        if need_ctx:
            filt_c = hyena_filters(n_ctx, hy_filt_w1[l], hy_filt_b1[l], hy_filt_w2[l], hy_filt_b2[l],
                                   hy_filt_w3[l], hy_freq[l])
            hy_c = hyena_mixer(hyc, hy_short_w[l], hy_short_b[l], filt_c, hy_bias[l]).astype(xc.dtype)
            xc = xc + cga1 * (merge_branches(att_c, hg_c, hy_c, gtc, w_branch[l]) @ w_out[l])

        xl = xl + ga2 * sq_relu_mlp(rms_norm(xl, norm2_g[l]) * (1.0 + sc2) + sh2, w_mlp1[l], w_mlp2[l])
        if need_ctx:
            xc = xc + cga2 * sq_relu_mlp(rms_norm(xc, norm2_g[l]) * (1.0 + csc2) + csh2,
                                         w_mlp1[l], w_mlp2[l])
    return xl
```

```cpp
#include <hip/hip_runtime.h>
#include <hip/hip_bf16.h>
#include <hip/hip_cooperative_groups.h>
#include <cstdio>
#include <cstdint>
namespace cg = cooperative_groups;

__device__ __forceinline__ int otid() { int t = (int)threadIdx.x; asm volatile("" : "+v"(t)); return t; }

namespace pg8 {
#define PG8_LAS __attribute__((address_space(3)))
typedef unsigned short bf16_t;
typedef short bf16x8 __attribute__((ext_vector_type(8)));
typedef float f32x4 __attribute__((ext_vector_type(4)));
typedef unsigned u32x4 __attribute__((ext_vector_type(4)));
constexpr int BM = 256, BK = 64, HALF = 128, HTB = HALF * BK * 2  , STAGE_BYTES = 8 * HTB, NXCD = 8, WGM = 8;

__host__ __device__ __forceinline__ int lds_byte(int r, int c) { const int st = (r >> 4) * 2 + (c >> 5), rr = r & 15, cc = c & 31, ob = rr * 64 + cc * 2; return st * 1024 + (ob ^ (((ob >> 9) & 1) << 5)); }
__host__ __device__ __forceinline__ void stage_rc(int b, int& R, int& C) { const int st = b / 1024, sb = b % 1024, swz = sb ^ (((sb >> 9) & 1) << 5); R = (st >> 1) * 16 + swz / 64; C = (st & 1) * 32 + (swz % 64) / 2; }
__host__ __device__ __forceinline__ int perm32(int rho) { const int n = rho >> 4, i = rho & 15; return 8 * (i >> 2) + 4 * n + (i & 3); }

struct Unit { int pm, pn; };
struct Gemm { const bf16_t* A; const bf16_t* Bt; int M, N, K; };

struct StaticOrder {
    int nM, nN, nwg, G, c;
    __host__ __device__ void init(int M, int N, int G_, int c_) { nM = M / BM; nN = N / BM; nwg = nM * nN; G = G_; c = c_; }
    __host__ __device__ bool next(int i, Unit& u) const {
        const long L = (long)i * G + c; if (L >= nwg) return false;
        int wgid = (int)L; { const int q = nwg / NXCD, r = nwg % NXCD, xcd = wgid % NXCD, off = wgid / NXCD; wgid = (xcd < r ? xcd * (q + 1) : r * (q + 1) + (xcd - r) * q) + off; }
        const int nig = WGM * nN, gid = wgid / nig, fm = gid * WGM, gsz = (nM - fm) < WGM ? (nM - fm) : WGM;
        u.pm = fm + ((wgid % nig) % gsz); u.pn = (wgid % nig) / gsz; return true;
    }
    __device__ __forceinline__ void a_ready(const Unit&) const {}
    __device__ __forceinline__ void done(const Unit&) const {}
};
template <class Epi, class Sched, bool STAMP = false>
__device__ __forceinline__ void gemm_phase(PG8_LAS unsigned char* lds, const Gemm g, const Sched& S, const Epi& E, unsigned long long* stamps) {
    const int tid = otid(), wid = __builtin_amdgcn_readfirstlane(tid >> 6), lane = tid & 63, wr = wid >> 2, wc = wid & 3, fr = lane & 15, fq = lane >> 4;
    const int K = g.K, nt = K / BK;
    int ts_lo = 0, ts_hi = 0, nts = 0; const unsigned long long rt_entry = STAMP ? (unsigned long long)wall_clock64() : 0ull;
#define PG8_STAMP() do { if (STAMP && wid == 0 && nts < 64) { const unsigned long long _c = (unsigned long long)clock64(); \
        ts_lo = (lane == nts) ? (int)(unsigned)_c : ts_lo; ts_hi = (lane == nts) ? (int)(unsigned)(_c >> 32) : ts_hi; ++nts; } } while (0)
    PG8_STAMP();
    unsigned voffA[2], voffB[2];
#pragma unroll
    for (int i = 0; i < 2; ++i) { int R, C; stage_rc(tid * 16 + i * 8192, R, C); const int Rb = Epi::PERM ? ((R & ~31) + perm32(R & 31)) : R;
        voffA[i] = (unsigned)(R * K + C) * 2u; voffB[i] = (unsigned)(Rb * K + C) * 2u; }
    const size_t kstep = (size_t)(BK * 2);
    const size_t hstep = (size_t)HALF * K * 2;
    const size_t tstep = 2 * hstep;
    const unsigned ldsw = (unsigned)wid * 1024u;
    const int aoff = lds_byte(wr * 64 + fr, fq * 8), boff = lds_byte(wc * 32 + fr, fq * 8);
#define PG8_SA(b, h) (((b) * 2 + (h)) * HTB)
#define PG8_SB(b, h) ((4 + (b) * 2 + (h)) * HTB)
#define PG8_STAGE(bufoff, gbase, voff) do { _Pragma("unroll") for (int _i = 0; _i < 2; ++_i) \
        __builtin_amdgcn_global_load_lds((const unsigned*)((const char*)(gbase) + (voff)[_i]), (PG8_LAS unsigned*)(lds + (bufoff) + ldsw + _i * 8192), 16, 0, 0); } while (0)
#define PG8_LDA(dst, b, h) do { _Pragma("unroll") for (int m = 0; m < 4; ++m) _Pragma("unroll") for (int k = 0; k < 2; ++k) dst[m][k] = *(const PG8_LAS bf16x8*)(lds + PG8_SA(b, h) + aoff + m * 2048 + k * 1024); } while (0)
#define PG8_LDB(dst, b, h) do { _Pragma("unroll") for (int n = 0; n < 2; ++n) _Pragma("unroll") for (int k = 0; k < 2; ++k) dst[n][k] = *(const PG8_LAS bf16x8*)(lds + PG8_SB(b, h) + boff + n * 2048 + k * 1024); } while (0)
#define PG8_MMA(ai, bj, At, Bt) do { __builtin_amdgcn_s_setprio(1); _Pragma("unroll") for (int m = 0; m < 4; ++m) _Pragma("unroll") for (int n = 0; n < 2; ++n) _Pragma("unroll") for (int k = 0; k < 2; ++k) \
        acc[ai][bj][m][n] = __builtin_amdgcn_mfma_f32_16x16x32_bf16(Bt[n][k], At[m][k], acc[ai][bj][m][n], 0, 0, 0); __builtin_amdgcn_s_setprio(0); } while (0)
#define PG8_WAIT_V(n) asm volatile("s_waitcnt vmcnt(" #n ")" ::: "memory")
#define PG8_WAIT_L(n) asm volatile("s_waitcnt lgkmcnt(" #n ")" ::: "memory")
#define PG8_BAR __builtin_amdgcn_s_barrier()
#define PG8_SCHED __builtin_amdgcn_sched_barrier(0)
    Unit cur, nxt; int ui = 0;
    if (!S.next(0, cur)) return;
    f32x4 acc[2][2][4][2];
#pragma unroll
    for (int a = 0; a < 2; ++a)
#pragma unroll
        for (int b = 0; b < 2; ++b)
#pragma unroll
            for (int m = 0; m < 4; ++m)
#pragma unroll
                for (int n = 0; n < 2; ++n) acc[a][b][m][n] = (f32x4){0.f, 0.f, 0.f, 0.f};
    bf16x8 At[4][2], B0[2][2], B1[2][2];
    const char* cA = (const char*)g.A + (size_t)cur.pm * tstep; const char* cB = (const char*)g.Bt + (size_t)cur.pn * tstep;
    S.a_ready(cur);
    PG8_STAGE(PG8_SB(0, 0), cB, voffB); PG8_STAGE(PG8_SA(0, 0), cA, voffA); PG8_STAGE(PG8_SB(0, 1), cB + hstep, voffB); PG8_STAGE(PG8_SA(0, 1), cA + hstep, voffA);
    if (wr == 1) PG8_BAR;
    PG8_WAIT_V(4); PG8_BAR;
    PG8_STAGE(PG8_SB(1, 0), cB + kstep, voffB); PG8_STAGE(PG8_SA(1, 0), cA + kstep, voffA); PG8_STAGE(PG8_SB(1, 1), cB + hstep + kstep, voffB);
    PG8_WAIT_V(6); PG8_BAR;
    PG8_STAMP();
    for (;;) {
        const bool has_next = S.next(ui + 1, nxt);
        const char* nA = has_next ? (const char*)g.A + (size_t)nxt.pm * tstep : cA; const char* nB = has_next ? (const char*)g.Bt + (size_t)nxt.pn * tstep : cB;
        for (int t = 0; t < nt; t += 2) {
            const bool last = (t == nt - 2);
            const char* a1 = cA + (size_t)(t + 1) * kstep;
            const char* a2 = last ? nA : cA + (size_t)(t + 2) * kstep; const char* b2 = last ? nB : cB + (size_t)(t + 2) * kstep;
            const char* a3 = a2 + kstep; const char* b3 = b2 + kstep;
            if (last && has_next) S.a_ready(nxt);
            PG8_LDB(B0, 0, 0); PG8_SCHED; PG8_LDA(At, 0, 0); PG8_STAGE(PG8_SA(1, 1), a1 + hstep, voffA);
            PG8_WAIT_L(8); PG8_BAR; PG8_WAIT_L(0); PG8_MMA(0, 0, At, B0); PG8_BAR; PG8_SCHED;
            PG8_LDB(B1, 0, 1); PG8_STAGE(PG8_SB(0, 0), b2, voffB);
            PG8_BAR; PG8_WAIT_L(0); PG8_MMA(0, 1, At, B1); PG8_BAR;
            PG8_LDA(At, 0, 1); PG8_STAGE(PG8_SA(0, 0), a2, voffA);
            PG8_BAR; PG8_WAIT_L(0); PG8_MMA(1, 0, At, B0); PG8_BAR; PG8_SCHED;
            PG8_STAGE(PG8_SB(0, 1), b2 + hstep, voffB);
            PG8_WAIT_V(6); PG8_BAR; PG8_MMA(1, 1, At, B1); PG8_BAR;
            PG8_LDB(B0, 1, 0); PG8_SCHED; PG8_LDA(At, 1, 0); PG8_STAGE(PG8_SA(0, 1), a2 + hstep, voffA);
            PG8_WAIT_L(8); PG8_BAR; PG8_WAIT_L(0); PG8_MMA(0, 0, At, B0); PG8_BAR; PG8_SCHED;
            PG8_LDB(B1, 1, 1); PG8_STAGE(PG8_SB(1, 0), b3, voffB);
            PG8_BAR; PG8_WAIT_L(0); PG8_MMA(0, 1, At, B1); PG8_BAR;
            PG8_LDA(At, 1, 1); PG8_STAGE(PG8_SA(1, 0), a3, voffA);
            PG8_BAR; PG8_WAIT_L(0); PG8_MMA(1, 0, At, B0); PG8_BAR; PG8_SCHED;
            PG8_STAGE(PG8_SB(1, 1), b3 + hstep, voffB);
            PG8_WAIT_V(6); PG8_BAR; PG8_MMA(1, 1, At, B1); PG8_BAR;
        }
        PG8_STAMP();
        if constexpr (!Epi::AFTER_DRAIN) { E(acc, cur, wr, wc, fr, fq); S.done(cur); }
        PG8_STAMP();
        if (!has_next) break;
#pragma unroll
        for (int a = 0; a < 2; ++a)
#pragma unroll
            for (int b = 0; b < 2; ++b)
#pragma unroll
                for (int m = 0; m < 4; ++m)
#pragma unroll
                    for (int n = 0; n < 2; ++n) acc[a][b][m][n] = (f32x4){0.f, 0.f, 0.f, 0.f};
        cur = nxt; cA = nA; cB = nB; ++ui;
    }
    PG8_WAIT_V(0);
    if (wr == 0) PG8_BAR;
    PG8_BAR;
    if constexpr (Epi::AFTER_DRAIN) { E.fused(acc, cur, wr, wc, fr, fq, lds, wid, lane); S.done(cur); }
    PG8_STAMP();
    if (STAMP && wid == 0) { stamps[lane] = lane < nts ? (((unsigned long long)(unsigned)ts_hi << 32) | (unsigned)ts_lo) : 0ull;
        if (lane == 62) stamps[62] = rt_entry; if (lane == 63) stamps[63] = (unsigned long long)wall_clock64(); }
#undef PG8_STAMP
#undef PG8_SA
#undef PG8_SB
#undef PG8_STAGE
#undef PG8_LDA
#undef PG8_LDB
#undef PG8_MMA
#undef PG8_WAIT_V
#undef PG8_WAIT_L
#undef PG8_BAR
#undef PG8_SCHED
}
}

namespace att {
using bf16 = __hip_bfloat16;
constexpr int   D = 128, NW = 8, QBLK = 32, KVBLK = 64;
constexpr float SCALE = 0.088388347648318440f;
constexpr float THR = 0.f;
constexpr int SDEPTH = 2;
constexpr int LDQ = 1536, LDK = 1536, LDO = 1024;
constexpr size_t SHM_V = KVBLK * D * 2, SHM_K = KVBLK * D * 2, SHM_ATTN = 2 * SHM_V + 2 * SHM_K + NW * 64 * 4;
using bf16x8 = __attribute__((ext_vector_type(8))) short;
using s16x4  = __attribute__((ext_vector_type(4))) short;
using f32x16 = __attribute__((ext_vector_type(16))) float;
using f32x8  = __attribute__((ext_vector_type(8))) float;
using u32x4  = __attribute__((ext_vector_type(4))) unsigned;
#define KSWZ(row, colB) ((row) * 256 + ((colB) ^ (((row) & 7) << 4)))
#define SBAR() __builtin_amdgcn_sched_barrier(0)
__device__ __forceinline__ int crow(int r, int hi) { return (r & 3) + 8 * (r >> 2) + 4 * hi; }
__device__ __forceinline__ unsigned cvtpk(float lo, float hi) {
  unsigned r; asm volatile("v_cvt_pk_bf16_f32 %0, %1, %2" : "=v"(r) : "v"(lo), "v"(hi)); return r;
}
template <typename TIn> struct Stage;
template <> struct Stage<bf16>  { using T = bf16x8;
  __device__ static __forceinline__ T ld8(const bf16* p) { return *reinterpret_cast<const bf16x8*>(p); }
  __device__ static __forceinline__ bf16x8 tobf(T x) { return x; } };
template <> struct Stage<float> { using T = f32x8;
  __device__ static __forceinline__ T ld8(const float* p) { return *reinterpret_cast<const f32x8*>(p); }
  __device__ static __forceinline__ bf16x8 tobf(T x) {
    u32x4 w = {cvtpk(x[0], x[1]), cvtpk(x[2], x[3]), cvtpk(x[4], x[5]), cvtpk(x[6], x[7])}; return *reinterpret_cast<bf16x8*>(&w); } };

__device__ __forceinline__ void partialSM(f32x16& p0, f32x16& p1, float& m_reg, float& mn, float& alpha) {
  constexpr float C = SCALE * 1.4426950408889634f;
  float pmax = p0[0]; for (int r = 1; r < 16; ++r) pmax = fmaxf(pmax, p0[r]); for (int r = 0; r < 16; ++r) pmax = fmaxf(pmax, p1[r]);
  { auto rr = __builtin_amdgcn_permlane32_swap(__float_as_uint(pmax), __float_as_uint(pmax), false, false);
    pmax = fmaxf(__uint_as_float(rr[0]), __uint_as_float(rr[1])); }
  if (__builtin_expect(__all(pmax - m_reg <= THR / SCALE), 1)) { mn = m_reg; alpha = 1.f; }
  else { mn = fmaxf(m_reg, pmax); alpha = __builtin_amdgcn_exp2f((m_reg - mn) * C); m_reg = mn; }
  float mnC = -mn * C;
  for (int r = 0; r < 16; ++r) p0[r] = fmaf(p0[r], C, mnC); for (int r = 0; r < 16; ++r) p1[r] = fmaf(p1[r], C, mnC);
  for (int r = 0; r < 16; ++r) p0[r] = __builtin_amdgcn_exp2f(p0[r]);
}
__device__ __forceinline__ void finishSM(f32x16& p0, f32x16& p1, float alpha, float& l_reg, bf16x8& pa0, bf16x8& pa1, bf16x8& pa2, bf16x8& pa3) {
  for (int r = 0; r < 16; ++r) p1[r] = __builtin_amdgcn_exp2f(p1[r]);
  float ps = 0; for (int r = 0; r < 16; ++r) ps += p0[r]; for (int r = 0; r < 16; ++r) ps += p1[r];
  { auto rr = __builtin_amdgcn_permlane32_swap(__float_as_uint(ps), __float_as_uint(ps), false, false);
    ps = __uint_as_float(rr[0]) + __uint_as_float(rr[1]); }
  l_reg = l_reg * alpha + ps;
#define PK4(P, BASE, OUT) do { unsigned a0 = cvtpk(P[BASE + 0], P[BASE + 1]), a1 = cvtpk(P[BASE + 2], P[BASE + 3]);   \
    unsigned b0 = cvtpk(P[BASE + 4], P[BASE + 5]), b1 = cvtpk(P[BASE + 6], P[BASE + 7]);                              \
    auto r0 = __builtin_amdgcn_permlane32_swap(a0, b0, false, false); auto r1 = __builtin_amdgcn_permlane32_swap(a1, b1, false, false); \
    u32x4 w = {r0[0], r1[0], r0[1], r1[1]}; OUT = *reinterpret_cast<bf16x8*>(&w); } while (0)
  PK4(p0, 0, pa0); PK4(p0, 8, pa1); PK4(p1, 0, pa2); PK4(p1, 8, pa3);
#undef PK4
}
__device__ __forceinline__ void qkt(f32x16& p0, f32x16& p1, const bf16* Ks, const bf16x8* qr, int r32, int hi) {
  p0 = f32x16{}; p1 = f32x16{};
  for (int d0 = 0; d0 < 8; ++d0) { int cb = (d0 * 16 + hi * 8) * 2;
    bf16x8 b0 = *reinterpret_cast<const bf16x8*>((const char*)Ks + KSWZ(r32, cb));
    bf16x8 b1 = *reinterpret_cast<const bf16x8*>((const char*)Ks + KSWZ(32 + r32, cb));
    p0 = __builtin_amdgcn_mfma_f32_32x32x16_bf16(b0, qr[d0], p0, 0, 0, 0);
    p1 = __builtin_amdgcn_mfma_f32_32x32x16_bf16(b1, qr[d0], p1, 0, 0, 0); }
}
__device__ __forceinline__ int v_st(int k, int c) { const int kk = (k & ~0xC) | ((k & 4) << 1) | ((k & 8) >> 1); return ((kk >> 3) * 4 + (c >> 5)) * 512 + ((kk & 7) * 32 + (c & 31)) * 2; }
__device__ __forceinline__ int v_rd_base(int lane) { return ((lane & 3) << 3) | (((lane >> 2) & 3) << 6) | (((lane >> 4) & 1) << 5) | (((lane >> 5) & 1) << 8); }
constexpr int v_rd_off(int d0, int ks, int half) { return d0 * 512 + ks * 4096 + half * 2048; }
template <int OFF> __device__ __forceinline__ s16x4 tr_read(int vb) {
  s16x4 r; asm volatile("ds_read_b64_tr_b16 %0, %1 offset:%2" : "=&v"(r) : "v"(vb), "i"(OFF) : "memory"); return r;
}
template <int D0> __device__ __forceinline__ void pv_one(f32x16& od, int vb, bf16x8 pa0, bf16x8 pa1, bf16x8 pa2, bf16x8 pa3) {
  const s16x4 l0 = tr_read<v_rd_off(D0, 0, 0)>(vb), h0 = tr_read<v_rd_off(D0, 0, 1)>(vb), l1 = tr_read<v_rd_off(D0, 1, 0)>(vb), h1 = tr_read<v_rd_off(D0, 1, 1)>(vb);
  const s16x4 l2 = tr_read<v_rd_off(D0, 2, 0)>(vb), h2 = tr_read<v_rd_off(D0, 2, 1)>(vb), l3 = tr_read<v_rd_off(D0, 3, 0)>(vb), h3 = tr_read<v_rd_off(D0, 3, 1)>(vb);
  asm volatile("s_waitcnt lgkmcnt(0)" ::: "memory"); SBAR();
#define PK(L, H) (bf16x8){L[0], L[1], L[2], L[3], H[0], H[1], H[2], H[3]}
  od = __builtin_amdgcn_mfma_f32_32x32x16_bf16(pa0, PK(l0, h0), od, 0, 0, 0);
  od = __builtin_amdgcn_mfma_f32_32x32x16_bf16(pa1, PK(l1, h1), od, 0, 0, 0);
  od = __builtin_amdgcn_mfma_f32_32x32x16_bf16(pa2, PK(l2, h2), od, 0, 0, 0);
  od = __builtin_amdgcn_mfma_f32_32x32x16_bf16(pa3, PK(l3, h3), od, 0, 0, 0);
#undef PK
}
__device__ __forceinline__ void pv_d0(f32x16* o, int vb, bf16x8 pa0, bf16x8 pa1, bf16x8 pa2, bf16x8 pa3) {
  pv_one<0>(o[0], vb, pa0, pa1, pa2, pa3); pv_one<1>(o[1], vb, pa0, pa1, pa2, pa3); pv_one<2>(o[2], vb, pa0, pa1, pa2, pa3); pv_one<3>(o[3], vb, pa0, pa1, pa2, pa3);
}

template <typename TQ>
__device__ __forceinline__ void attn_dense_body(const TQ* __restrict__ Qb, const bf16* __restrict__ Kh, const bf16* __restrict__ Vh,
                                                unsigned short* __restrict__ Ob, int seq, char* lds) {
  using St = Stage<bf16>; using SQ = Stage<TQ>;
  const int tid = otid(), wid = tid >> 6, lane = tid & 63, r32 = lane & 31, hi = lane >> 5;
  bf16* V_lds = (bf16*)lds; bf16* K_lds = (bf16*)(lds + 2 * SHM_V);
  float* ws = (float*)(lds + 2 * SHM_V + 2 * SHM_K) + wid * 64; float* li_l = ws; float* al_l = ws + 32;
  float m_reg = -1e30f, l_reg = 0; f32x16 o[4] = {}; bf16x8 qr[8];
  const TQ* Qw = Qb + (long)(wid * QBLK + r32) * LDQ + hi * 8;
#pragma unroll
  for (int d0 = 0; d0 < 8; ++d0) qr[d0] = SQ::tobf(SQ::ld8(Qw + d0 * 16));
  const int sr = tid >> 4, sc = (tid & 15) * 8, vst0 = v_st(sr, sc), vst1 = v_st(32 + sr, sc);
  const int vb0 = (int)(uintptr_t)V_lds + v_rd_base(lane);
  struct { typename St::T vs0, vs1, ks0, ks1; } sr_[SDEPTH];
#define SLOAD(i, k0) do { sr_[i].vs0 = St::ld8(&Vh[(long)((k0) + sr) * LDK + sc]); sr_[i].vs1 = St::ld8(&Vh[(long)((k0) + 32 + sr) * LDK + sc]); \
    sr_[i].ks0 = St::ld8(&Kh[(long)((k0) + sr) * LDK + sc]); sr_[i].ks1 = St::ld8(&Kh[(long)((k0) + 32 + sr) * LDK + sc]); } while (0)
#define SWRITE(b, i) do { *(bf16x8*)((char*)V_lds + (b) * SHM_V + vst0) = St::tobf(sr_[i].vs0);          \
    *(bf16x8*)((char*)V_lds + (b) * SHM_V + vst1) = St::tobf(sr_[i].vs1); int kc = sc * 2;               \
    *(bf16x8*)((char*)K_lds + (b) * SHM_K + KSWZ(sr, kc)) = St::tobf(sr_[i].ks0);                       \
    *(bf16x8*)((char*)K_lds + (b) * SHM_K + KSWZ(32 + sr, kc)) = St::tobf(sr_[i].ks1); } while (0)
#define SWAIT() do { if constexpr (SDEPTH == 2) asm volatile("s_waitcnt vmcnt(4)" ::: "memory"); else asm volatile("s_waitcnt vmcnt(0)" ::: "memory"); } while (0)
#define RESC(a) do { if (__any((a) < 1.f)) { if (hi == 0) al_l[r32] = (a); asm volatile("s_waitcnt lgkmcnt(0)" ::: "memory"); \
    for (int d = 0; d < 4; ++d) for (int r = 0; r < 16; ++r) o[d][r] *= al_l[crow(r, hi)]; } } while (0)
  f32x16 pA0, pA1, pB0, pB1; float mnA, mnB, alA, alB; bf16x8 pa0, pa1, pa2, pa3; const int NT = seq / KVBLK;
  constexpr int SE = 0, SO = SDEPTH - 1;
  SLOAD(SE, 0); asm volatile("s_waitcnt vmcnt(0)" ::: "memory"); SWRITE(0, SE); __syncthreads();
  qkt(pA0, pA1, K_lds, qr, r32, hi); partialSM(pA0, pA1, m_reg, mnA, alA);
  SLOAD(SO, KVBLK); if constexpr (SDEPTH == 2) { if (2 < NT) SLOAD(SE, 2 * KVBLK); }
  SWAIT(); SWRITE(1, SO); __syncthreads();
  for (int j = 1; j + 1 < NT; j += 2) {
    SBAR(); qkt(pB0, pB1, (bf16*)((char*)K_lds + SHM_K), qr, r32, hi);
    finishSM(pA0, pA1, alA, l_reg, pa0, pa1, pa2, pa3); SBAR();
    SLOAD(SO, (j + SDEPTH) * KVBLK); SBAR();
    pv_d0(o, vb0, pa0, pa1, pa2, pa3); partialSM(pB0, pB1, m_reg, mnB, alB);
    __syncthreads(); SWAIT(); SWRITE(0, SE);
    RESC(alB); __syncthreads();
    SBAR(); qkt(pA0, pA1, K_lds, qr, r32, hi);
    finishSM(pB0, pB1, alB, l_reg, pa0, pa1, pa2, pa3); SBAR();
    if (SDEPTH == 1 || j + 3 < NT) SLOAD(SE, (j + 1 + SDEPTH) * KVBLK); SBAR();
    pv_d0(o, vb0 + (int)SHM_V, pa0, pa1, pa2, pa3); partialSM(pA0, pA1, m_reg, mnA, alA);
    __syncthreads(); SWAIT(); SWRITE(1, SO);
    RESC(alA); __syncthreads();
  }
  SBAR(); qkt(pB0, pB1, (bf16*)((char*)K_lds + SHM_K), qr, r32, hi);
  finishSM(pA0, pA1, alA, l_reg, pa0, pa1, pa2, pa3); SBAR();
  pv_d0(o, vb0, pa0, pa1, pa2, pa3); partialSM(pB0, pB1, m_reg, mnB, alB);
  __syncthreads(); RESC(alB);
  finishSM(pB0, pB1, alB, l_reg, pa0, pa1, pa2, pa3); SBAR();
  pv_d0(o, vb0 + (int)SHM_V, pa0, pa1, pa2, pa3);
  if (hi == 0) li_l[r32] = l_reg; asm volatile("s_waitcnt lgkmcnt(0)" ::: "memory");
  float rli[16];
#pragma unroll
  for (int r = 0; r < 16; ++r) rli[r] = __builtin_amdgcn_rcpf(li_l[crow(r, hi)]);
  unsigned short* Ow = Ob + (long)(wid * QBLK) * LDO;
#pragma unroll
  for (int r = 0; r < 16; ++r) { int orow = crow(r, hi);
    for (int d0 = 0; d0 < 4; ++d0) Ow[(long)orow * LDO + d0 * 32 + r32] = (unsigned short)(cvtpk(o[d0][r] * rli[r], 0.f) & 0xffffu); }
#undef SLOAD
#undef SWRITE
#undef SWAIT
#undef RESC
}
}

using pg8::bf16_t; using pg8::bf16x8; using pg8::f32x4; using pg8::u32x4; using pg8::Unit;
typedef unsigned u32x2 __attribute__((ext_vector_type(2)));
constexpr int NB = 8, RPB = 2304  , T = NB * RPB, NIN = 12800;
constexpr size_t AL(size_t x) { return (x + 255) & ~(size_t)255; }
constexpr size_t SZ_TD   = (size_t)T * 1024 * 2;
constexpr size_t WS_MODS = 0;
constexpr size_t WS_HIDF = WS_MODS + AL((size_t)2 * 9 * 6144 * 4);
constexpr size_t WS_XC   = WS_HIDF + AL((size_t)2 * 2304 * 64 * 4);
constexpr size_t WS_WIN  = WS_XC + AL((size_t)8 * 256 * 1024 * 4);
constexpr size_t WS_WBR  = WS_WIN + (size_t)NIN * 1024 * 2;
constexpr size_t WS_WOUT = WS_WBR + (size_t)3 * 1024 * 1024 * 2;
constexpr size_t WS_WM1  = WS_WOUT + (size_t)1024 * 1024 * 2;
constexpr size_t WS_WM2  = WS_WM1 + (size_t)4096 * 1024 * 2;
constexpr size_t WS_H    = WS_WM2 + (size_t)4096 * 1024 * 2;
constexpr size_t WS_ARENA = WS_H + SZ_TD;
constexpr size_t WS_ATT = WS_ARENA, WS_HG = WS_ARENA + SZ_TD, WS_S = WS_ARENA + 2 * SZ_TD;
constexpr size_t WS_QKV = WS_S;
constexpr size_t WS_ZH  = WS_S;
constexpr size_t WS_OFB = WS_S + (size_t)T * 2560 * 2;
constexpr size_t WS_UT  = WS_S;
constexpr size_t WS_G = WS_S, WS_HY = WS_S + SZ_TD, WS_MRG = WS_S + 2 * SZ_TD;
constexpr size_t WS_HID4 = WS_ARENA;
constexpr size_t WS_END = WS_OFB + (size_t)2 * T * 512 * 2;
constexpr int LDS_BYTES = 147456;

struct Params {
    const float *x, *c, *ctx, *c_ctx, *ada_w, *ada_b, *norm1_g, *norm2_g, *w_in, *q_norm_g, *k_norm_g, *hg_lb_raw, *hg_norm_g, *hy_short_w, *hy_short_b,
        *hy_filt_w1, *hy_filt_b1, *hy_filt_w2, *hy_filt_b2, *hy_filt_w3, *hy_freq, *hy_bias, *w_branch, *w_out, *w_mlp1, *w_mlp2;
    float* out; unsigned char* ws;
};
typedef const __attribute__((address_space(4))) Params* PP;

__device__ __forceinline__ unsigned pk2(float lo, float hi) { unsigned r; asm volatile("v_cvt_pk_bf16_f32 %0, %1, %2" : "=v"(r) : "v"(lo), "v"(hi)); return r; }
__device__ __forceinline__ bf16_t f2bf(float x) { return (bf16_t)(pk2(x, 0.f) & 0xffffu); }
__device__ __forceinline__ float bf2f(bf16_t v) { return __uint_as_float(((unsigned)v) << 16); }
__device__ __forceinline__ float wave_sum(float v) {
#pragma unroll
    for (int o = 32; o > 0; o >>= 1) v += __shfl_xor(v, o);
    return v;
}

struct Sched {
    int nM, nN, nwg, G, c, skip;
    __device__ __forceinline__ void init(int nM_, int nN_, int G_, int c_, int skip_) { nM = nM_; nN = nN_; nwg = nM_ * nN_; G = G_; c = c_; skip = skip_; }
    __device__ __forceinline__ bool next(int i, Unit& u) const {
        const long L = (long)i * G + c; if (L >= nwg) return false;
        int wgid = (int)L; { const int q = nwg / 8, r = nwg % 8, xcd = wgid % 8, off = wgid / 8; wgid = (xcd < r ? xcd * (q + 1) : r * (q + 1) + (xcd - r) * q) + off; }
        const int nig = 8 * nN, gid = wgid / nig, fm = gid * 8, gsz = (nM - fm) < 8 ? (nM - fm) : 8;
        u.pm = fm + ((wgid % nig) % gsz); u.pn = (wgid % nig) / gsz;
        if (skip) u.pm += u.pm / 8 + 1;
        return true;
    }
    __device__ __forceinline__ void a_ready(const Unit&) const {}
    __device__ __forceinline__ void done(const Unit&) const {}
};

template <int ACT  > struct EpiBf {
    static constexpr bool PERM = true, AFTER_DRAIN = false;
    bf16_t* O; int ldc;
    __device__ __forceinline__ void operator()(const f32x4 (&acc)[2][2][4][2], const Unit& u, int wr, int wc, int fr, int fq) const {
        const int row0 = u.pm * 256 + wr * 64 + fr, col0 = u.pn * 256 + wc * 32 + 8 * fq;
#pragma unroll
        for (int ai = 0; ai < 2; ++ai)
#pragma unroll
            for (int m = 0; m < 4; ++m) { bf16_t* rowp = O + (size_t)(row0 + ai * 128 + m * 16) * ldc + col0;
#pragma unroll
                for (int bj = 0; bj < 2; ++bj) { f32x4 v0 = acc[ai][bj][m][0], v1 = acc[ai][bj][m][1];
                    if (ACT == 1) {
#pragma unroll
                        for (int j = 0; j < 4; ++j) { v0[j] = 1.f / (1.f + __expf(-v0[j])); v1[j] = 1.f / (1.f + __expf(-v1[j])); } }
                    if (ACT == 2) {
#pragma unroll
                        for (int j = 0; j < 4; ++j) { float a = fmaxf(v0[j], 0.f), b = fmaxf(v1[j], 0.f); v0[j] = a * a; v1[j] = b * b; } }
                    u32x4 w; w.x = pk2(v0[0], v0[1]); w.y = pk2(v0[2], v0[3]); w.z = pk2(v1[0], v1[1]); w.w = pk2(v1[2], v1[3]);
                    *(u32x4*)(rowp + bj * 128) = w; } }
    }
};
struct EpiMerge {
    static constexpr bool PERM = true, AFTER_DRAIN = false;
    const bf16_t* G; bf16_t* MRG; int first;
    __device__ __forceinline__ void operator()(const f32x4 (&acc)[2][2][4][2], const Unit& u, int wr, int wc, int fr, int fq) const {
        const int row0 = u.pm * 256 + wr * 64 + fr, col0 = u.pn * 256 + wc * 32 + 8 * fq;
#pragma unroll
        for (int ai = 0; ai < 2; ++ai)
#pragma unroll
            for (int m = 0; m < 4; ++m) { const size_t ro = (size_t)(row0 + ai * 128 + m * 16) * 1024 + col0;
#pragma unroll
                for (int bj = 0; bj < 2; ++bj) {
                    const u32x4 g = *(const u32x4*)(G + ro + bj * 128);
                    u32x4 o = {0u, 0u, 0u, 0u}; if (!first) o = *(const u32x4*)(MRG + ro + bj * 128);
                    float r[8];
#pragma unroll
                    for (int j = 0; j < 4; ++j) {
                        const float a0 = (j < 2 ? acc[ai][bj][m][0][2 * j] : acc[ai][bj][m][1][2 * j - 4]), a1 = (j < 2 ? acc[ai][bj][m][0][2 * j + 1] : acc[ai][bj][m][1][2 * j - 3]);
                        r[2 * j]     = __uint_as_float(o[j] << 16) + __uint_as_float(g[j] << 16) * a0;
                        r[2 * j + 1] = __uint_as_float(o[j] & 0xffff0000u) + __uint_as_float(g[j] & 0xffff0000u) * a1; }
                    u32x4 w; w.x = pk2(r[0], r[1]); w.y = pk2(r[2], r[3]); w.z = pk2(r[4], r[5]); w.w = pk2(r[6], r[7]);
                    *(u32x4*)(MRG + ro + bj * 128) = w; } }
    }
};
struct EpiResid {
    static constexpr bool PERM = false, AFTER_DRAIN = false;
    float* x_lat; float* x_ctx; const float* mods_l; int goff;
    __device__ __forceinline__ void operator()(const f32x4 (&acc)[2][2][4][2], const Unit& u, int wr, int wc, int fr, int fq) const {
        const int b = u.pm / 9, pt = u.pm % 9;
        float* xp; const float* gate;
        if (pt == 0) { xp = x_ctx + (size_t)b * 256 * 1024; gate = mods_l + 8 * 6144 + goff; }
        else { xp = x_lat + ((size_t)b * 2048 + (size_t)(pt - 1) * 256) * 1024; gate = mods_l + b * 6144 + goff; }
        const int lr0 = wr * 64 + fr, col0 = u.pn * 256 + wc * 32 + 4 * fq;
#pragma unroll
        for (int ai = 0; ai < 2; ++ai)
#pragma unroll
            for (int m = 0; m < 4; ++m) { const unsigned ro = (unsigned)(lr0 + ai * 128 + m * 16) * 1024u + (unsigned)col0;
                __builtin_amdgcn_sched_barrier(0);
#pragma unroll
                for (int bj = 0; bj < 2; ++bj)
#pragma unroll
                    for (int n = 0; n < 2; ++n) { const f32x4 xi = *(const f32x4*)(xp + ro + bj * 128 + n * 16); const f32x4 gq = *(const f32x4*)(gate + col0 + bj * 128 + n * 16);
                        *(f32x4*)(xp + ro + bj * 128 + n * 16) = xi + gq * acc[ai][bj][m][n]; } }
    }
};

template <class Epi>
__device__ __forceinline__ void run_gemm(unsigned char* smem, const bf16_t* A, const bf16_t* Bt, int nM, int nN, int K, int rot, int skip, const Epi& E) {
    pg8::Gemm g{A, Bt, nM * 256, nN * 256, K};
    Sched S; S.init(nM, nN, (int)gridDim.x, (int)((blockIdx.x + (unsigned)rot) % gridDim.x), skip);
    pg8::gemm_phase<Epi, Sched, false>((PG8_LAS unsigned char*)smem, g, S, E, nullptr);
}

__device__ __forceinline__ int mapcol(int n) {
    if (n < 1536 || n >= 6656) return n;
    const int x = n - 1536, hh = x / 2560, y = x % 2560, role = y / 512, j = y % 512;
    return 1536 + role * 1024 + hh * 512 + j;
}
__device__ void conv_weights(PP p, int l, unsigned char* smem) {
    float* tile = (float*)smem;
    const int tid = otid();
    for (int g = blockIdx.x; g < 6272; g += gridDim.x) {
        const float* src; int ld, col0, K, k0, drow0; bf16_t* dst;
        if (g < 3200) { const int nt = g >> 4, kt = g & 15; src = p->w_in + (size_t)l * 1024 * NIN; ld = NIN; drow0 = nt * 64; col0 = mapcol(drow0); K = 1024; k0 = kt * 64; dst = (bf16_t*)(p->ws + WS_WIN); }
        else if (g < 3968) { const int q = g - 3200, i = q >> 8, r = q & 255, nt = r >> 4, kt = r & 15; src = p->w_branch + ((size_t)l * 3 + i) * 1024 * 1024; ld = 1024; drow0 = nt * 64; col0 = drow0; K = 1024; k0 = kt * 64; dst = (bf16_t*)(p->ws + WS_WBR) + (size_t)i * 1024 * 1024; }
        else if (g < 4224) { const int q = g - 3968, nt = q >> 4, kt = q & 15; src = p->w_out + (size_t)l * 1024 * 1024; ld = 1024; drow0 = nt * 64; col0 = drow0; K = 1024; k0 = kt * 64; dst = (bf16_t*)(p->ws + WS_WOUT); }
        else if (g < 5248) { const int q = g - 4224, nt = q >> 4, kt = q & 15; src = p->w_mlp1 + (size_t)l * 1024 * 4096; ld = 4096; drow0 = nt * 64; col0 = drow0; K = 1024; k0 = kt * 64; dst = (bf16_t*)(p->ws + WS_WM1); }
        else { const int q = g - 5248, nt = q >> 6, kt = q & 63; src = p->w_mlp2 + (size_t)l * 4096 * 1024; ld = 1024; drow0 = nt * 64; col0 = drow0; K = 4096; k0 = kt * 64; dst = (bf16_t*)(p->ws + WS_WM2); }
        { const int kk = tid >> 4, n4 = (tid & 15) * 4;
          const float4 a = *(const float4*)(src + (size_t)(k0 + kk) * ld + col0 + n4);
          const float4 b = *(const float4*)(src + (size_t)(k0 + kk + 32) * ld + col0 + n4);
          float* t0 = tile + kk * 65 + n4; t0[0] = a.x; t0[1] = a.y; t0[2] = a.z; t0[3] = a.w;
          float* t1 = tile + (kk + 32) * 65 + n4; t1[0] = b.x; t1[1] = b.y; t1[2] = b.z; t1[3] = b.w; }
        __syncthreads();
        { const int n = tid >> 3, k8 = (tid & 7) * 8; float v[8];
#pragma unroll
          for (int j = 0; j < 8; ++j) v[j] = tile[(k8 + j) * 65 + n];
          u32x4 w; w.x = pk2(v[0], v[1]); w.y = pk2(v[2], v[3]); w.z = pk2(v[4], v[5]); w.w = pk2(v[6], v[7]);
          *(u32x4*)(dst + (size_t)(drow0 + n) * K + k0 + k8) = w; }
        __syncthreads();
    }
}
__device__ void prep_hid(PP p) {
    const int lane = otid() & 63, gw = blockIdx.x * 8 + (otid() >> 6), nw = gridDim.x * 8;
    float* HID = (float*)(p->ws + WS_HIDF);
    for (int item = gw; item < 2 * 2304; item += nw) {
        const int l = item / 2304, r = item % 2304; int n, i; if (r < 2048) { n = 2048; i = r; } else { n = 256; i = r - 2048; }
        const float ti = (float)i / (float)(n - 1), wi = (6.283185307179586f / (float)n) * (float)i;
        const float* w1 = p->hy_filt_w1 + (size_t)l * 33 * 64;
        float acc = p->hy_filt_b1[l * 64 + lane] + ti * w1[lane];
        for (int m = 0; m < 16; ++m) { const float fm = 1e-4f + (float)m * ((15.f - 1e-4f) / 15.f); float s, c; sincosf(fm * wi, &s, &c);
            acc += c * w1[(1 + m) * 64 + lane] - s * w1[(17 + m) * 64 + lane]; }
        const float h1 = sinf(p->hy_freq[(l * 2 + 0) * 64 + lane] * acc);
        const float* w2 = p->hy_filt_w2 + (size_t)l * 64 * 64;
        float acc2 = p->hy_filt_b2[l * 64 + lane];
        for (int jj = 0; jj < 64; ++jj) acc2 += __shfl(h1, jj) * w2[jj * 64 + lane];
        HID[((size_t)l * 2304 + r) * 64 + lane] = sinf(p->hy_freq[(l * 2 + 1) * 64 + lane] * acc2);
    }
}
__device__ void prep_mods(PP p, unsigned char* smem) {
    float* s = (float*)smem; float* part = s + 9 * 1024; float* MODS = (float*)(p->ws + WS_MODS);
    const int tid = otid();
    for (int bi = blockIdx.x; bi < 192; bi += gridDim.x) {
        __syncthreads();
        for (int e = tid; e < 9 * 1024; e += 512) { const int j = e >> 10, d = e & 1023; const float cv = (j < 8) ? p->c[j * 1024 + d] : p->c_ctx[d]; s[e] = cv / (1.f + expf(-cv)); }
        __syncthreads();
        const int l = bi / 96, e0 = (bi % 96) * 64, ec = tid & 63, ds = tid >> 6;
        float acc[9];
#pragma unroll
        for (int j = 0; j < 9; ++j) acc[j] = 0.f;
        const float* w = p->ada_w + ((size_t)l * 1024 + ds * 128) * 6144 + e0 + ec;
#pragma unroll 4
        for (int d = 0; d < 128; ++d) { const float wv = w[(size_t)d * 6144];
#pragma unroll
            for (int j = 0; j < 9; ++j) acc[j] += s[j * 1024 + ds * 128 + d] * wv; }
#pragma unroll
        for (int j = 0; j < 9; ++j) part[(ds * 9 + j) * 64 + ec] = acc[j];
        __syncthreads();
        for (int o = tid; o < 576; o += 512) { const int j = o >> 6, e2 = o & 63; float sum = 0.f;
            for (int d2 = 0; d2 < 8; ++d2) sum += part[(d2 * 9 + j) * 64 + e2];
            MODS[((size_t)l * 9 + j) * 6144 + e0 + e2] = sum + p->ada_b[l * 6144 + e0 + e2]; }
    }
    __syncthreads();
}

__device__ void phase_norm(PP p, int l, int which, const float* xl, const float* xc) {
    const int lane = otid() & 63, gw = blockIdx.x * 8 + (otid() >> 6), nw = gridDim.x * 8;
    const float* g = (which ? p->norm2_g : p->norm1_g) + l * 1024;
    const int shoff = which ? 3072 : 0, scoff = which ? 4096 : 1024;
    const float* MODS = (const float*)(p->ws + WS_MODS);
    bf16_t* H = (bf16_t*)(p->ws + WS_H);
    for (int r = gw; r < T; r += nw) {
        const int b = r / RPB, pp = r % RPB;
        const float* src = pp < 256 ? xc + ((size_t)b * 256 + pp) * 1024 : xl + ((size_t)b * 2048 + (pp - 256)) * 1024;
        const float* md = MODS + ((size_t)l * 9 + (pp < 256 ? 8 : b)) * 6144;
        float4 v[4]; float ss = 0.f;
#pragma unroll
        for (int i = 0; i < 4; ++i) { v[i] = *(const float4*)(src + i * 256 + lane * 4); ss += v[i].x * v[i].x + v[i].y * v[i].y + v[i].z * v[i].z + v[i].w * v[i].w; }
        ss = wave_sum(ss); const float rstd = 1.0f / sqrtf(ss * (1.f / 1024.f) + 1e-6f);
#pragma unroll
        for (int i = 0; i < 4; ++i) { const int col = i * 256 + lane * 4;
            const float4 gg = *(const float4*)(g + col), sc = *(const float4*)(md + scoff + col), sh = *(const float4*)(md + shoff + col);
            u32x2 w; w.x = pk2(v[i].x * rstd * gg.x * (1.f + sc.x) + sh.x, v[i].y * rstd * gg.y * (1.f + sc.y) + sh.y);
            w.y = pk2(v[i].z * rstd * gg.z * (1.f + sc.z) + sh.z, v[i].w * rstd * gg.w * (1.f + sc.w) + sh.w);
            *(u32x2*)(H + (size_t)r * 1024 + col) = w; }
    }
}
__device__ void phase_qkprep(PP p, int l) {
    const int lane = otid() & 63, gw = blockIdx.x * 8 + (otid() >> 6), nw = gridDim.x * 8;
    bf16_t* QKV = (bf16_t*)(p->ws + WS_QKV);
    const float inv = powf(10000.f, -(float)(lane & 31) / 32.f);
    for (int item = gw; item < T * 10; item += nw) {
        const int r = item / 10, hd = item % 10, pp = r % RPB;
        bf16_t* ptr = QKV + (size_t)r * 1536 + hd * 128;
        const float* g = (hd < 8 ? p->q_norm_g : p->k_norm_g) + l * 128;
        const float x0 = bf2f(ptr[lane]), x1 = bf2f(ptr[64 + lane]);
        const float ss = wave_sum(x0 * x0 + x1 * x1); const float rstd = 1.0f / sqrtf(ss * (1.f / 128.f) + 1e-6f);
        float y0 = x0 * rstd * g[lane], y1 = x1 * rstd * g[64 + lane];
        if (pp >= 256) { const int t = pp - 256; const float a0 = (float)(t >> 6) * inv, a1 = (float)(t & 63) * inv;
            float s0, c0, s1, c1; sincosf(a0, &s0, &c0); sincosf(a1, &s1, &c1);
            const float p0 = __shfl_xor(y0, 32), p1 = __shfl_xor(y1, 32);
            const float r0 = (lane < 32) ? -p0 : p0, r1 = (lane < 32) ? -p1 : p1;
            y0 = y0 * c0 + r0 * s0; y1 = y1 * c1 + r1 * s1; }
        ptr[lane] = f2bf(y0); ptr[64 + lane] = f2bf(y1);
    }
}
__device__ void phase_readout(PP p, int l, int hh) {
    const int lane = otid() & 63, gw = blockIdx.x * 8 + (otid() >> 6), nw = gridDim.x * 8;
    const bf16_t* ZH = (const bf16_t*)(p->ws + WS_ZH); const bf16_t* OFB = (const bf16_t*)(p->ws + WS_OFB); bf16_t* HG = (bf16_t*)(p->ws + WS_HG);
    const float gn0 = p->hg_norm_g[l * 128 + lane], gn1 = p->hg_norm_g[l * 128 + 64 + lane];
    for (int item = gw; item < T * 4; item += nw) {
        const int r = item >> 2, hl = item & 3;
        const size_t oa = (size_t)r * 512 + hl * 128 + lane, ob = ((size_t)T + r) * 512 + hl * 128 + lane;
        const float o0 = bf2f(OFB[oa]) + bf2f(OFB[ob]), o1 = bf2f(OFB[oa + 64]) + bf2f(OFB[ob + 64]);
        const float ss = wave_sum(o0 * o0 + o1 * o1); const float rstd = 1.0f / sqrtf(ss * (1.f / 128.f) + 1e-6f);
        const float g0 = bf2f(ZH[(size_t)r * 2560 + 4 * 512 + hl * 128 + lane]), g1 = bf2f(ZH[(size_t)r * 2560 + 4 * 512 + hl * 128 + 64 + lane]);
        HG[(size_t)r * 1024 + (hh * 4 + hl) * 128 + lane] = f2bf(o0 * rstd * gn0 * (g0 / (1.f + expf(-g0))));
        HG[(size_t)r * 1024 + (hh * 4 + hl) * 128 + 64 + lane] = f2bf(o1 * rstd * gn1 * (g1 / (1.f + expf(-g1))));
    }
}
__device__ void phase_transpose(PP p, unsigned char* smem) {
    bf16_t* tile = (bf16_t*)smem;
    const bf16_t* HYT = (const bf16_t*)(p->ws + WS_UT); bf16_t* HY = (bf16_t*)(p->ws + WS_HY);
    const int tid = otid();
    for (int g = blockIdx.x; g < (T / 64) * 16; g += gridDim.x) {
        const int t0 = (g >> 4) * 64, c0 = (g & 15) * 64;
        { const int cr = tid >> 3, t8 = (tid & 7) * 8; *(u32x4*)(tile + cr * 72 + t8) = *(const u32x4*)(HYT + (size_t)(c0 + cr) * T + t0 + t8); }
        __syncthreads();
        { const int tr = tid >> 3, c8 = (tid & 7) * 8; bf16_t v[8];
#pragma unroll
          for (int j = 0; j < 8; ++j) v[j] = tile[(c8 + j) * 72 + tr];
          u32x4 w; w.x = v[0] | ((unsigned)v[1] << 16); w.y = v[2] | ((unsigned)v[3] << 16); w.z = v[4] | ((unsigned)v[5] << 16); w.w = v[6] | ((unsigned)v[7] << 16);
          *(u32x4*)(HY + (size_t)(t0 + tr) * 1024 + c0 + c8) = w; }
        __syncthreads();
    }
}

__device__ void phase_attn(PP p, int l, unsigned char* smem) {
    const att::bf16* QKV = (const att::bf16*)(p->ws + WS_QKV); bf16_t* ATT = (bf16_t*)(p->ws + WS_ATT);
    const int nitems = 512 + (l == 0 ? 64 : 0);
    for (int it = blockIdx.x; it < nitems; it += gridDim.x) {
        int b, h, seq; size_t r0;
        if (it < 512) { b = it >> 6; h = (it >> 3) & 7; r0 = (size_t)b * RPB + 256 + (size_t)(it & 7) * 256; seq = RPB; }
        else { const int q = it - 512; b = q >> 3; h = q & 7; r0 = (size_t)b * RPB; seq = 256; }
        __syncthreads();
        const att::bf16* Kp = QKV + (size_t)b * RPB * 1536 + 1024 + (h >> 2) * 128;
        att::attn_dense_body<att::bf16>(QKV + r0 * 1536 + h * 128, Kp, Kp + 256, ATT + r0 * 1024 + h * 128, seq, (char*)smem);
    }
    __syncthreads();
}

#define MFMA16(a, b, c) __builtin_amdgcn_mfma_f32_16x16x32_bf16(a, b, c, 0, 0, 0)
__device__ void phase_scan(PP p, int l, int hh, unsigned char* smem) {
    bf16_t* Qhat = (bf16_t*)smem;
    bf16_t* Qtil = Qhat + 64 * 136;
    bf16_t* Khat = Qtil + 64 * 136;
    bf16_t* KtT  = Khat + 160 * 136;
    bf16_t* Vt   = KtT + 128 * 72;
    bf16_t* Pm   = Vt + 32 * 72;
    bf16_t* St   = Pm + 64 * 72;
    float* segsum = (float*)(St + 32 * 136);
    float* dvec = segsum + 512;
    const bf16_t* ZH = (const bf16_t*)(p->ws + WS_ZH); bf16_t* OFB = (bf16_t*)(p->ws + WS_OFB);
    const int tid = otid(), lane = tid & 63, wid = tid >> 6, k = tid & 127, seg = tid >> 7, li = lane & 15, lg = lane >> 4;
    for (int item = blockIdx.x; item < 256; item += gridDim.x) {
        const int vq = item & 3, dir = (item >> 2) & 1, hl = (item >> 3) & 3, b = item >> 5, h = hh * 4 + hl;
        float lb = 0.f;
        if (l > 0) { const float r0 = p->hg_lb_raw[(0 * 2 + dir) * 1024 + h * 128 + k], r1 = p->hg_lb_raw[(1 * 2 + dir) * 1024 + h * 128 + k];
            const float mx = fmaxf(r0, r1), e0 = expf(r0 - mx), e1 = expf(r1 - mx); const float s0 = e0 / (e0 + e1), s1 = e1 / (e0 + e1); lb = (s0 + s1) - s0; }
        const float oml = 1.f - lb;
        __syncthreads();
        for (int e = tid; e < 32 * 136; e += 512) St[e] = 0;
        for (int e = tid; e < 64 * 72; e += 512) Pm[e] = 0;
        f32x4 sacc[2] = {{0.f, 0.f, 0.f, 0.f}, {0.f, 0.f, 0.f, 0.f}};
        bf16_t zr[16], qr[16]; u32x4 vr = {0u, 0u, 0u, 0u};
        const size_t rb = (size_t)b * RPB;
        const int zcol = (1 + dir) * 512 + hl * 128 + k, qcol = hl * 128 + k, vcol = 3 * 512 + hl * 128 + vq * 32 + (tid & 3) * 8;
        const int sgn = dir ? -1 : 1;
#define SCAN_START(cc) (dir == 0 ? 64 * (cc) : ((cc) < 4 ? 255 - 64 * (cc) : 256 + 2047 - 64 * ((cc) - 4)))
#define SCAN_LOAD(cc) do { const int st_ = SCAN_START(cc); \
        _Pragma("unroll") for (int r = 0; r < 16; ++r) { const size_t row_ = rb + (size_t)(st_ + sgn * (seg * 16 + r)); zr[r] = ZH[row_ * 2560 + zcol]; qr[r] = ZH[row_ * 2560 + qcol]; } \
        if (tid < 256) { const size_t row_ = rb + (size_t)(st_ + sgn * (tid >> 2)); vr = *(const u32x4*)(ZH + row_ * 2560 + vcol); } } while (0)
        SCAN_LOAD(0);
        for (int c = 0; c < 36; ++c) {
            const int start = SCAN_START(c);
            float cum[16], kk[16], qv[16]; float run = 0.f;
#pragma unroll
            for (int r = 0; r < 16; ++r) { const float z = bf2f(zr[r]); const float sg = 1.f / (1.f + expf(-z)), sgm = 1.f / (1.f + expf(z));
                const float f = lb + oml * sg; run += logf(fmaxf(f, 1e-6f)); cum[r] = run; kk[r] = oml * sgm; qv[r] = bf2f(qr[r]); }
            segsum[seg * 128 + k] = run;
            const u32x4 vcur = vr;
            __syncthreads();
            if (c + 1 < 36) SCAN_LOAD(c + 1);
            const float s0 = segsum[k], s1 = segsum[128 + k], s2 = segsum[256 + k], s3 = segsum[384 + k];
            const float c01 = s0, c02 = s0 + s1, c03 = s0 + s1 + s2, last = c03 + s3;
            const float myc0 = seg == 0 ? 0.f : (seg == 1 ? c01 : (seg == 2 ? c02 : c03));
            unsigned ktp[8];
#pragma unroll
            for (int r = 0; r < 16; ++r) { const int t = seg * 16 + r; const float cl = cum[r], ca = myc0 + cl;
                Qhat[t * 136 + k] = f2bf(qv[r] * expf(cl));
                Qtil[t * 136 + k] = f2bf(qv[r] * expf(ca));
                if (seg == 0) Khat[(0 + t) * 136 + k]  = f2bf(kk[r] * expf(fminf(0.f - ca, 60.f)));
                if (seg <= 1) Khat[(16 + t) * 136 + k] = f2bf(kk[r] * expf(fminf(c01 - ca, 60.f)));
                if (seg <= 2) Khat[(48 + t) * 136 + k] = f2bf(kk[r] * expf(fminf(c02 - ca, 60.f)));
                Khat[(96 + t) * 136 + k] = f2bf(kk[r] * expf(fminf(c03 - ca, 60.f)));
                const unsigned kt = f2bf(kk[r] * expf(last - ca));
                if (r & 1) ktp[r >> 1] |= kt << 16; else ktp[r >> 1] = kt; }
            { u32x4 w0 = {ktp[0], ktp[1], ktp[2], ktp[3]}, w1 = {ktp[4], ktp[5], ktp[6], ktp[7]};
              *(u32x4*)(KtT + k * 72 + seg * 16) = w0; *(u32x4*)(KtT + k * 72 + seg * 16 + 8) = w1; }
            if (seg == 0) dvec[k] = expf(last);
            if (tid < 256) { const int s = tid >> 2, v8 = (tid & 3) * 8;
#pragma unroll
                for (int j = 0; j < 4; ++j) { Vt[(v8 + 2 * j) * 72 + s] = (bf16_t)(vcur[j] & 0xffffu); Vt[(v8 + 2 * j + 1) * 72 + s] = (bf16_t)(vcur[j] >> 16); } }
            __syncthreads();
            for (int idx = wid; idx < 10; idx += 8) {
                const int I = idx >= 6 ? 3 : (idx >= 3 ? 2 : (idx >= 1 ? 1 : 0)), J = idx - I * (I + 1) / 2, koff = I == 0 ? 0 : (I == 1 ? 16 : (I == 2 ? 48 : 96));
                f32x4 acc = {0.f, 0.f, 0.f, 0.f};
#pragma unroll
                for (int ks = 0; ks < 4; ++ks) { const bf16x8 a = *(const bf16x8*)(Qhat + (16 * I + li) * 136 + ks * 32 + lg * 8);
                    const bf16x8 bb = *(const bf16x8*)(Khat + (koff + 16 * J + li) * 136 + ks * 32 + lg * 8); acc = MFMA16(a, bb, acc); }
#pragma unroll
                for (int r = 0; r < 4; ++r) { const int tl = 4 * lg + r; float v = acc[r]; if (I == J && li > tl) v = 0.f; Pm[(16 * I + tl) * 72 + 16 * J + li] = f2bf(v); }
            }
            __syncthreads();
            { const int tI = wid >> 1, vJ = wid & 1; f32x4 acc = {0.f, 0.f, 0.f, 0.f};
#pragma unroll
              for (int ks = 0; ks < 4; ++ks) { const bf16x8 a = *(const bf16x8*)(Qtil + (16 * tI + li) * 136 + ks * 32 + lg * 8);
                  const bf16x8 bb = *(const bf16x8*)(St + (16 * vJ + li) * 136 + ks * 32 + lg * 8); acc = MFMA16(a, bb, acc); }
#pragma unroll
              for (int ks = 0; ks < 2; ++ks) { const bf16x8 a = *(const bf16x8*)(Pm + (16 * tI + li) * 72 + ks * 32 + lg * 8);
                  const bf16x8 bb = *(const bf16x8*)(Vt + (16 * vJ + li) * 72 + ks * 32 + lg * 8); acc = MFMA16(a, bb, acc); }
#pragma unroll
              for (int r = 0; r < 4; ++r) { const int t = 16 * tI + 4 * lg + r; const size_t row = rb + (size_t)(start + sgn * t);
                  OFB[((size_t)dir * T + row) * 512 + hl * 128 + vq * 32 + 16 * vJ + li] = f2bf(acc[r]); } }
            { const int vI = wid & 1;
#pragma unroll
              for (int jj = 0; jj < 2; ++jj) { const int kJ = (wid >> 1) * 2 + jj; const float dk = dvec[16 * kJ + li];
                  sacc[jj] = sacc[jj] * dk;
#pragma unroll
                  for (int ks = 0; ks < 2; ++ks) { const bf16x8 a = *(const bf16x8*)(Vt + (16 * vI + li) * 72 + ks * 32 + lg * 8);
                      const bf16x8 bb = *(const bf16x8*)(KtT + (16 * kJ + li) * 72 + ks * 32 + lg * 8); sacc[jj] = MFMA16(a, bb, sacc[jj]); } } }
            __syncthreads();
            { const int vI = wid & 1;
#pragma unroll
              for (int jj = 0; jj < 2; ++jj) { const int kJ = (wid >> 1) * 2 + jj;
#pragma unroll
                  for (int r = 0; r < 4; ++r) St[(16 * vI + 4 * lg + r) * 136 + 16 * kJ + li] = f2bf(sacc[jj][r]); } }
        }
#undef SCAN_LOAD
#undef SCAN_START
    }
    __syncthreads();
}

__device__ __forceinline__ float2 cmul(float2 a, float2 b) { return make_float2(a.x * b.x - a.y * b.y, a.x * b.y + a.y * b.x); }
template <int M, bool INV>
__device__ __forceinline__ void fft_r4(float2*& x, float2*& y, const float2* tw, int nseq, int tid) {
    constexpr int NP = (M == 4096) ? 6 : 5, Q = M / 4, TS = 4096 / M;
#pragma unroll 1
    for (int ps = 0; ps < NP; ++ps) {
        const int sh = 2 * ps, s = 1 << sh, n1 = Q >> sh;
        for (int idx = tid; idx < nseq * Q; idx += 512) {
            const int sq = idx / Q, j = idx % Q, pq = j >> sh, q = j & (s - 1);
            float2 w1 = tw[(pq << sh) * TS]; if (INV) w1.y = -w1.y;
            const float2 w2 = cmul(w1, w1), w3 = cmul(w2, w1);
            const float2* xs = x + sq * M + q + s * pq; float2* ys = y + sq * M + q + s * 4 * pq;
            const float2 a = xs[0], b = xs[s * n1], c = xs[2 * s * n1], d = xs[3 * s * n1];
            const float2 apc = make_float2(a.x + c.x, a.y + c.y), amc = make_float2(a.x - c.x, a.y - c.y);
            const float2 bpd = make_float2(b.x + d.x, b.y + d.y), bmd = make_float2(b.x - d.x, b.y - d.y);
            const float2 jb = INV ? make_float2(bmd.y, -bmd.x) : make_float2(-bmd.y, bmd.x);
            ys[0] = make_float2(apc.x + bpd.x, apc.y + bpd.y);
            ys[s] = cmul(w1, make_float2(amc.x - jb.x, amc.y - jb.y));
            ys[2 * s] = cmul(w2, make_float2(apc.x - bpd.x, apc.y - bpd.y));
            ys[3 * s] = cmul(w3, make_float2(amc.x + jb.x, amc.y + jb.y));
        }
        __syncthreads();
        float2* t = x; x = y; y = t;
    }
}
constexpr float HY_MIN_DECAY_C = -3.0701134573253945f, HY_MAX_DECAY_C = -15.350567286626972f;

template <int N, int M>
__device__ __forceinline__ void hyena_filter(PP p, int l, int c, const float* hid, float2*& x, float2*& y, float2* Hs0, float2* Hs1, const float2* tw, float* w3s, float* red) {
    const int tid = otid(), lane = tid & 63, wid = tid >> 6;
    if (tid < 256) { const int q = tid >> 6, j = tid & 63; w3s[tid] = p->hy_filt_w3[((size_t)l * 64 + j) * 4096 + (q >> 1) * 2048 + (q & 1) * 1024 + c]; }
    for (int e = tid; e < M; e += 512) x[e] = make_float2(0.f, 0.f);
    __syncthreads();
    const float delta = fabsf(HY_MIN_DECAY_C + (float)c * ((HY_MAX_DECAY_C - HY_MIN_DECAY_C) / 1023.f));
    constexpr int NL = (N + 511) / 512;
    float fw0[NL], fw1[NL], bw0[NL], bw1[NL]; float as0 = 0.f, as1 = 0.f;
#pragma unroll
    for (int jl = 0; jl < NL; ++jl) { const int i = tid + 512 * jl; fw0[jl] = fw1[jl] = bw0[jl] = bw1[jl] = 0.f;
        if (i < N) { const float ti = (float)i / (float)(N - 1), dec = expf(-ti * delta); const float* hr = hid + (size_t)i * 64;
            float d0 = 0.f, d1 = 0.f, d2 = 0.f, d3 = 0.f;
#pragma unroll 1
            for (int j = 0; j < 64; j += 4) { const float4 hv = *(const float4*)(hr + j);
                d0 += hv.x * w3s[j] + hv.y * w3s[j + 1] + hv.z * w3s[j + 2] + hv.w * w3s[j + 3];
                d1 += hv.x * w3s[64 + j] + hv.y * w3s[64 + j + 1] + hv.z * w3s[64 + j + 2] + hv.w * w3s[64 + j + 3];
                d2 += hv.x * w3s[128 + j] + hv.y * w3s[128 + j + 1] + hv.z * w3s[128 + j + 2] + hv.w * w3s[128 + j + 3];
                d3 += hv.x * w3s[192 + j] + hv.y * w3s[192 + j + 1] + hv.z * w3s[192 + j + 2] + hv.w * w3s[192 + j + 3]; }
            fw0[jl] = d0 * dec; bw0[jl] = d1 * dec; fw1[jl] = d2 * dec; bw1[jl] = d3 * dec;
            as0 += fabsf(fw0[jl]) + (i >= 1 ? fabsf(bw0[jl]) : 0.f); as1 += fabsf(fw1[jl]) + (i >= 1 ? fabsf(bw1[jl]) : 0.f); } }
    as0 = wave_sum(as0); as1 = wave_sum(as1);
    if (lane == 0) { red[wid * 2] = as0; red[wid * 2 + 1] = as1; }
    __syncthreads();
    float t0 = 0.f, t1 = 0.f;
#pragma unroll
    for (int w = 0; w < 8; ++w) { t0 += red[w * 2]; t1 += red[w * 2 + 1]; }
    const float sc0 = 1.f / (t0 + 1e-6f), sc1 = 1.f / (t1 + 1e-6f);
#pragma unroll
    for (int jl = 0; jl < NL; ++jl) { const int i = tid + 512 * jl;
        if (i < N) { x[i] = make_float2(fw0[jl] * sc0, fw1[jl] * sc1); if (i >= 1) x[M - i] = make_float2(bw0[jl] * sc0, bw1[jl] * sc1); } }
    __syncthreads();
    fft_r4<M, false>(x, y, tw, 1, tid);
    constexpr float HSC = 0.5f / (float)M;
    for (int kx = tid; kx < M; kx += 512) { const float2 zk = x[kx], zm = x[(M - kx) & (M - 1)];
        Hs0[kx] = make_float2(HSC * (zk.x + zm.x), HSC * (zk.y - zm.y));
        Hs1[kx] = make_float2(HSC * (zk.y + zm.y), -HSC * (zk.x - zm.x)); }
    __syncthreads();
}
template <int N, int M, int NSEQ>
__device__ __forceinline__ void hyena_seqs(PP p, int l, int c, int pair0, int tokoff, float2*& x, float2*& y, const float2* Hs0, const float2* Hs1, const float2* tw, bf16_t* UT) {
    const int tid = otid();
    constexpr int NE = N * NSEQ / 512;
    float sw[3][3], sb[3];
#pragma unroll
    for (int sec = 0; sec < 3; ++sec) { sb[sec] = p->hy_short_b[l * 3072 + sec * 1024 + c];
#pragma unroll
        for (int tap = 0; tap < 3; ++tap) sw[sec][tap] = p->hy_short_w[((size_t)l * 3 + tap) * 3072 + sec * 1024 + c]; }
    const float bias0 = p->hy_bias[(l * 2 + 0) * 1024 + c], bias1 = p->hy_bias[(l * 2 + 1) * 1024 + c];
#define HY_SCONV(sec, pr, t, out) do { const bf16_t* u0_ = UT + (size_t)((sec) * 1024 + c) * T + (size_t)(2 * (pr)) * RPB + tokoff; const bf16_t* u1_ = u0_ + RPB; \
        const float a0_ = (t) > 0 ? bf2f(u0_[(t) - 1]) : 0.f, a1_ = bf2f(u0_[(t)]), a2_ = (t) < N - 1 ? bf2f(u0_[(t) + 1]) : 0.f; \
        const float b0_ = (t) > 0 ? bf2f(u1_[(t) - 1]) : 0.f, b1_ = bf2f(u1_[(t)]), b2_ = (t) < N - 1 ? bf2f(u1_[(t) + 1]) : 0.f; \
        out = make_float2(a0_ * sw[sec][0] + a1_ * sw[sec][1] + a2_ * sw[sec][2] + sb[sec], b0_ * sw[sec][0] + b1_ * sw[sec][1] + b2_ * sw[sec][2] + sb[sec]); } while (0)
    float2 vz[NE], z1[NE];
#pragma unroll
    for (int j = 0; j < NE; ++j) { const int e = tid + 512 * j, pl = e / N, t = e % N; HY_SCONV(2, pair0 + pl, t, vz[j]); x[pl * M + t] = vz[j]; }
    for (int e = tid; e < NSEQ * (M - N); e += 512) { const int pl = e / (M - N), t = N + e % (M - N); x[pl * M + t] = make_float2(0.f, 0.f); }
    __syncthreads();
    fft_r4<M, false>(x, y, tw, NSEQ, tid);
    for (int e = tid; e < NSEQ * M; e += 512) x[e] = cmul(x[e], Hs0[e & (M - 1)]);
    __syncthreads();
    fft_r4<M, true>(x, y, tw, NSEQ, tid);
#pragma unroll
    for (int j = 0; j < NE; ++j) { const int e = tid + 512 * j, pl = e / N, t = e % N; const float2 zc = x[pl * M + t]; float2 x1; HY_SCONV(0, pair0 + pl, t, x1);
        z1[j] = make_float2(x1.x * (zc.x + vz[j].x * bias0), x1.y * (zc.y + vz[j].y * bias0)); }
    __syncthreads();
#pragma unroll
    for (int j = 0; j < NE; ++j) { const int e = tid + 512 * j, pl = e / N, t = e % N; x[pl * M + t] = z1[j]; }
    for (int e = tid; e < NSEQ * (M - N); e += 512) { const int pl = e / (M - N), t = N + e % (M - N); x[pl * M + t] = make_float2(0.f, 0.f); }
    __syncthreads();
    fft_r4<M, false>(x, y, tw, NSEQ, tid);
    for (int e = tid; e < NSEQ * M; e += 512) x[e] = cmul(x[e], Hs1[e & (M - 1)]);
    __syncthreads();
    fft_r4<M, true>(x, y, tw, NSEQ, tid);
#pragma unroll
    for (int j = 0; j < NE; ++j) { const int e = tid + 512 * j, pl = e / N, t = e % N; const float2 zc = x[pl * M + t]; float2 x2; HY_SCONV(1, pair0 + pl, t, x2);
        bf16_t* o0 = UT + (size_t)c * T + (size_t)(2 * (pair0 + pl)) * RPB + tokoff + t;
        o0[0] = f2bf(x2.x * (zc.x + z1[j].x * bias1)); o0[RPB] = f2bf(x2.y * (zc.y + z1[j].y * bias1)); }
    __syncthreads();
#undef HY_SCONV
}
__device__ void phase_hyena(PP p, int l, unsigned char* smem) {
    float2* x = (float2*)smem; float2* y = x + 4096; float2* Hs0 = y + 4096; float2* Hs1 = Hs0 + 4096; float2* tw = Hs1 + 4096;
    float* w3s = (float*)(tw + 1024); float* red = w3s + 256;
    const int tid = otid();
    bf16_t* UT = (bf16_t*)(p->ws + WS_UT);
    const float* HID = (const float*)(p->ws + WS_HIDF) + (size_t)l * 2304 * 64;
    __syncthreads();
    for (int e = tid; e < 1024; e += 512) { float s, c; sincospif((float)e / 2048.f, &s, &c); tw[e] = make_float2(c, -s); }
    __syncthreads();
    for (int c = blockIdx.x; c < 1024; c += gridDim.x) {
        hyena_filter<2048, 4096>(p, l, c, HID, x, y, Hs0, Hs1, tw, w3s, red);
#pragma unroll 1
        for (int pr = 0; pr < 4; ++pr) hyena_seqs<2048, 4096, 1>(p, l, c, pr, 256, x, y, Hs0, Hs1, tw, UT);
        if (l == 0) {
            hyena_filter<256, 1024>(p, l, c, HID + (size_t)2048 * 64, x, y, Hs0, Hs1, tw, w3s, red);
            hyena_seqs<256, 1024, 4>(p, l, c, 0, 0, x, y, Hs0, Hs1, tw, UT);
        }
    }
    __syncthreads();
}

constexpr int PH_PER_LAYER = 18, N_PHASES = 1 + 2 * PH_PER_LAYER;
__device__ __forceinline__ void run_phase(PP p, int ph, unsigned char* smem) {
#ifndef NO_PH0
    if (ph == 0) { conv_weights(p, 0, smem); prep_hid(p); prep_mods(p, smem);
        { const size_t gt = (size_t)blockIdx.x * 512 + otid(), gs = (size_t)gridDim.x * 512; float4* XC4 = (float4*)(p->ws + WS_XC);
          for (size_t i = gt; i < (size_t)8 * 2048 * 1024 / 4; i += gs) ((float4*)p->out)[i] = ((const float4*)p->x)[i];
          for (size_t i = gt; i < (size_t)8 * 256 * 1024 / 4; i += gs) XC4[i] = ((const float4*)p->ctx)[i]; }
        return; }
#endif
    const int l = (ph - 1) / PH_PER_LAYER, k = (ph - 1) % PH_PER_LAYER;
#ifndef PH_MASK
#define PH_MASK 0x3ffff
#endif
#define ON(kk) (((PH_MASK) >> (kk)) & 1)
    const float* xl_in = p->out; const float* xc_in = (const float*)(p->ws + WS_XC);
    float* XC = (float*)(p->ws + WS_XC);
    const bf16_t* H = (const bf16_t*)(p->ws + WS_H); const bf16_t* WIN = (const bf16_t*)(p->ws + WS_WIN);
    const float* mods_l = (const float*)(p->ws + WS_MODS) + (size_t)l * 9 * 6144;
    if (ON(0) && k == 0) { if (l > 0) conv_weights(p, l, smem); phase_norm(p, l, 0, xl_in, xc_in); }
    else if (ON(1) && (k == 1 || k == 4 || k == 7 || k == 10)) {
        const bf16_t* A = H; const bf16_t* Bt = WIN; int nM = 72, nN = 6; EpiBf<0> E{(bf16_t*)(p->ws + WS_QKV), 1536};
        if (k == 4 || k == 7) { Bt = WIN + (size_t)(1536 + (k == 7 ? 2560 : 0)) * 1024; nN = 10; E.O = (bf16_t*)(p->ws + WS_ZH); E.ldc = 2560; }
        if (k == 10) { A = WIN + (size_t)6656 * 1024; Bt = H; nM = 12; nN = 72; E.O = (bf16_t*)(p->ws + WS_UT); E.ldc = T; }
        run_gemm(smem, A, Bt, nM, nN, 1024, 0, 0, E);
    }
    else if (ON(2) && k == 2) phase_qkprep(p, l);
    else if (ON(3) && k == 3) phase_attn(p, l, smem);
    else if (ON(5) && (k == 5 || k == 8)) phase_scan(p, l, k == 8 ? 1 : 0, smem);
    else if (ON(6) && (k == 6 || k == 9)) phase_readout(p, l, k == 9 ? 1 : 0);
    else if (ON(11) && k == 11) phase_hyena(p, l, smem);
    else if (ON(12) && k == 12) phase_transpose(p, smem);
    else if (ON(13) && k == 13) {
#pragma unroll 1
        for (int i = 0; i < 3; ++i) {
            EpiBf<1> Eg{(bf16_t*)(p->ws + WS_G), 1024};
            run_gemm(smem, H, WIN + (size_t)(9728 + i * 1024) * 1024, 72, 4, 1024, 0, 0, Eg);
            const bf16_t* A = (const bf16_t*)(p->ws + (i == 0 ? WS_ATT : (i == 1 ? WS_HG : WS_HY)));
            EpiMerge Em{(const bf16_t*)(p->ws + WS_G), (bf16_t*)(p->ws + WS_MRG), i == 0 ? 1 : 0};
            run_gemm(smem, A, (const bf16_t*)(p->ws + WS_WBR) + (size_t)i * 1024 * 1024, 72, 4, 1024, 0, 0, Em);
        }
    }
    else if (ON(14) && (k == 14 || k == 17)) {
        EpiResid E{p->out, XC, mods_l, k == 14 ? 2048 : 5120};
        const bf16_t* A = (const bf16_t*)(p->ws + (k == 14 ? WS_MRG : WS_HID4)); const bf16_t* Bt = (const bf16_t*)(p->ws + (k == 14 ? WS_WOUT : WS_WM2));
        run_gemm(smem, A, Bt, 72, 4, k == 14 ? 1024 : 4096, 0, 0, E);
    }
    else if (ON(15) && k == 15) phase_norm(p, l, 1, p->out, XC);
    else if (ON(16) && k == 16) { EpiBf<2> E{(bf16_t*)(p->ws + WS_HID4), 4096}; run_gemm(smem, H, (const bf16_t*)(p->ws + WS_WM1), 72, 16, 1024, 0, 0, E); }
}

__global__ void __launch_bounds__(512, 2) hybrid_flow_megakernel(Params p, int ph_lo, int ph_hi) {
    extern __shared__ __attribute__((aligned(16))) unsigned char smem[];
    cg::grid_group grid = cg::this_grid();
    for (int ph = ph_lo; ph < ph_hi; ++ph) {
        PP pp = (PP)__builtin_amdgcn_kernarg_segment_ptr();
        asm volatile("" : "+s"(pp));
        run_phase(pp, ph, smem);
        if (ph + 1 < ph_hi) grid.sync();
    }
}

#ifndef N_LAUNCH_SPLIT
#define N_LAUNCH_SPLIT 0
#endif
extern "C" void kernel_launch(void* const* d_in, const int* in_sizes, int n_in, void* d_out, int out_size, void* d_ws, size_t ws_size, hipStream_t stream) {
    static int grid_blocks = 0;
    if (grid_blocks == 0) {
        if (n_in != 26 || ws_size < WS_END) { fprintf(stderr, "kernel_launch: n_in %d ws %zu need %zu\n", n_in, ws_size, (size_t)WS_END); grid_blocks = -1; return; }
        int dev = 0, cus = 0, per_cu = 0;
        hipGetDevice(&dev); hipDeviceGetAttribute(&cus, hipDeviceAttributeMultiprocessorCount, dev);
        if (hipFuncSetAttribute((const void*)hybrid_flow_megakernel, hipFuncAttributeMaxDynamicSharedMemorySize, LDS_BYTES) != hipSuccess) { fprintf(stderr, "kernel_launch: LDS attribute failed\n"); grid_blocks = -1; return; }
        if (hipOccupancyMaxActiveBlocksPerMultiprocessor(&per_cu, (const void*)hybrid_flow_megakernel, 512, LDS_BYTES) != hipSuccess || per_cu < 1) { fprintf(stderr, "kernel_launch: occupancy query failed (%d)\n", per_cu); grid_blocks = -1; return; }
        grid_blocks = cus * 1;
    }
    if (grid_blocks < 0) return;
    Params p{};
    const float** pp = (const float**)&p;
    for (int i = 0; i < 26; ++i) pp[i] = (const float*)d_in[i];
    p.out = (float*)d_out; p.ws = (unsigned char*)d_ws;
#if N_LAUNCH_SPLIT
    for (int ph = 0; ph < N_PHASES; ++ph) { int lo = ph, hi = ph + 1; void* args[] = {&p, &lo, &hi};
        hipLaunchCooperativeKernel((const void*)hybrid_flow_megakernel, dim3(grid_blocks), dim3(512), args, LDS_BYTES, stream); }
#else
    int lo = 0, hi = N_PHASES; void* args[] = {&p, &lo, &hi};
    hipError_t e = hipLaunchCooperativeKernel((const void*)hybrid_flow_megakernel, dim3(grid_blocks), dim3(512), args, LDS_BYTES, stream);
    if (e != hipSuccess) fprintf(stderr, "cooperative launch failed: %s (grid %d)\n", hipGetErrorString(e), grid_blocks);
#endif
}
```

```cpp
#include <hip/hip_runtime.h>
#include <hip/hip_bf16.h>
#include <hip/hip_cooperative_groups.h>
#include <cstdio>
#include <cstdint>
namespace cg = cooperative_groups;

__device__ __forceinline__ int otid() { int t = (int)threadIdx.x; asm volatile("" : "+v"(t)); return t; }

namespace pg8 {
#define PG8_LAS __attribute__((address_space(3)))
typedef unsigned short bf16_t;
typedef short bf16x8 __attribute__((ext_vector_type(8)));
typedef float f32x4 __attribute__((ext_vector_type(4)));
typedef unsigned u32x4 __attribute__((ext_vector_type(4)));
constexpr int BM = 256, BK = 64, HALF = 128, HTB = HALF * BK * 2  , STAGE_BYTES = 8 * HTB, NXCD = 8, WGM = 8;

__host__ __device__ __forceinline__ int lds_byte(int r, int c) { const int st = (r >> 4) * 2 + (c >> 5), rr = r & 15, cc = c & 31, ob = rr * 64 + cc * 2; return st * 1024 + (ob ^ (((ob >> 9) & 1) << 5)); }
__host__ __device__ __forceinline__ void stage_rc(int b, int& R, int& C) { const int st = b / 1024, sb = b % 1024, swz = sb ^ (((sb >> 9) & 1) << 5); R = (st >> 1) * 16 + swz / 64; C = (st & 1) * 32 + (swz % 64) / 2; }
__host__ __device__ __forceinline__ int perm32(int rho) { const int n = rho >> 4, i = rho & 15; return 8 * (i >> 2) + 4 * n + (i & 3); }

struct Unit { int pm, pn; };
struct Gemm { const bf16_t* A; const bf16_t* Bt; int M, N, K; };

struct StaticOrder {
    int nM, nN, nwg, G, c;
    __host__ __device__ void init(int M, int N, int G_, int c_) { nM = M / BM; nN = N / BM; nwg = nM * nN; G = G_; c = c_; }
    __host__ __device__ bool next(int i, Unit& u) const {
        const long L = (long)i * G + c; if (L >= nwg) return false;
        int wgid = (int)L; { const int q = nwg / NXCD, r = nwg % NXCD, xcd = wgid % NXCD, off = wgid / NXCD; wgid = (xcd < r ? xcd * (q + 1) : r * (q + 1) + (xcd - r) * q) + off; }
        const int nig = WGM * nN, gid = wgid / nig, fm = gid * WGM, gsz = (nM - fm) < WGM ? (nM - fm) : WGM;
        u.pm = fm + ((wgid % nig) % gsz); u.pn = (wgid % nig) / gsz; return true;
    }
    __device__ __forceinline__ void a_ready(const Unit&) const {}
    __device__ __forceinline__ void done(const Unit&) const {}
};
template <class Epi, class Sched, bool STAMP = false>
__device__ __forceinline__ void gemm_phase(PG8_LAS unsigned char* lds, const Gemm g, const Sched& S, const Epi& E, unsigned long long* stamps) {
    const int tid = otid(), wid = __builtin_amdgcn_readfirstlane(tid >> 6), lane = tid & 63, wr = wid >> 2, wc = wid & 3, fr = lane & 15, fq = lane >> 4;
    const int K = g.K, nt = K / BK;
    int ts_lo = 0, ts_hi = 0, nts = 0; const unsigned long long rt_entry = STAMP ? (unsigned long long)wall_clock64() : 0ull;
#define PG8_STAMP() do { if (STAMP && wid == 0 && nts < 64) { const unsigned long long _c = (unsigned long long)clock64(); \
        ts_lo = (lane == nts) ? (int)(unsigned)_c : ts_lo; ts_hi = (lane == nts) ? (int)(unsigned)(_c >> 32) : ts_hi; ++nts; } } while (0)
    PG8_STAMP();
    unsigned voffA[2], voffB[2];
#pragma unroll
    for (int i = 0; i < 2; ++i) { int R, C; stage_rc(tid * 16 + i * 8192, R, C); const int Rb = Epi::PERM ? ((R & ~31) + perm32(R & 31)) : R;
        voffA[i] = (unsigned)(R * K + C) * 2u; voffB[i] = (unsigned)(Rb * K + C) * 2u; }
    const size_t kstep = (size_t)(BK * 2);
    const size_t hstep = (size_t)HALF * K * 2;
    const size_t tstep = 2 * hstep;
    const unsigned ldsw = (unsigned)wid * 1024u;
    const int aoff = lds_byte(wr * 64 + fr, fq * 8), boff = lds_byte(wc * 32 + fr, fq * 8);
#define PG8_SA(b, h) (((b) * 2 + (h)) * HTB)
#define PG8_SB(b, h) ((4 + (b) * 2 + (h)) * HTB)
#define PG8_STAGE(bufoff, gbase, voff) do { _Pragma("unroll") for (int _i = 0; _i < 2; ++_i) \
        __builtin_amdgcn_global_load_lds((const unsigned*)((const char*)(gbase) + (voff)[_i]), (PG8_LAS unsigned*)(lds + (bufoff) + ldsw + _i * 8192), 16, 0, 0); } while (0)
#define PG8_LDA(dst, b, h) do { _Pragma("unroll") for (int m = 0; m < 4; ++m) _Pragma("unroll") for (int k = 0; k < 2; ++k) dst[m][k] = *(const PG8_LAS bf16x8*)(lds + PG8_SA(b, h) + aoff + m * 2048 + k * 1024); } while (0)
#define PG8_LDB(dst, b, h) do { _Pragma("unroll") for (int n = 0; n < 2; ++n) _Pragma("unroll") for (int k = 0; k < 2; ++k) dst[n][k] = *(const PG8_LAS bf16x8*)(lds + PG8_SB(b, h) + boff + n * 2048 + k * 1024); } while (0)
#define PG8_MMA(ai, bj, At, Bt) do { __builtin_amdgcn_s_setprio(1); _Pragma("unroll") for (int m = 0; m < 4; ++m) _Pragma("unroll") for (int n = 0; n < 2; ++n) _Pragma("unroll") for (int k = 0; k < 2; ++k) \
        acc[ai][bj][m][n] = __builtin_amdgcn_mfma_f32_16x16x32_bf16(Bt[n][k], At[m][k], acc[ai][bj][m][n], 0, 0, 0); __builtin_amdgcn_s_setprio(0); } while (0)
#define PG8_WAIT_V(n) asm volatile("s_waitcnt vmcnt(" #n ")" ::: "memory")
#define PG8_WAIT_L(n) asm volatile("s_waitcnt lgkmcnt(" #n ")" ::: "memory")
#define PG8_BAR __builtin_amdgcn_s_barrier()
#define PG8_SCHED __builtin_amdgcn_sched_barrier(0)
    Unit cur, nxt; int ui = 0;
    if (!S.next(0, cur)) return;
    f32x4 acc[2][2][4][2];
#pragma unroll
    for (int a = 0; a < 2; ++a)
#pragma unroll
        for (int b = 0; b < 2; ++b)
#pragma unroll
            for (int m = 0; m < 4; ++m)
#pragma unroll
                for (int n = 0; n < 2; ++n) acc[a][b][m][n] = (f32x4){0.f, 0.f, 0.f, 0.f};
    bf16x8 At[4][2], B0[2][2], B1[2][2];
    const char* cA = (const char*)g.A + (size_t)cur.pm * tstep; const char* cB = (const char*)g.Bt + (size_t)cur.pn * tstep;
    S.a_ready(cur);
    PG8_STAGE(PG8_SB(0, 0), cB, voffB); PG8_STAGE(PG8_SA(0, 0), cA, voffA); PG8_STAGE(PG8_SB(0, 1), cB + hstep, voffB); PG8_STAGE(PG8_SA(0, 1), cA + hstep, voffA);
    if (wr == 1) PG8_BAR;
    PG8_WAIT_V(4); PG8_BAR;
    PG8_STAGE(PG8_SB(1, 0), cB + kstep, voffB); PG8_STAGE(PG8_SA(1, 0), cA + kstep, voffA); PG8_STAGE(PG8_SB(1, 1), cB + hstep + kstep, voffB);
    PG8_WAIT_V(6); PG8_BAR;
    PG8_STAMP();
    for (;;) {
        const bool has_next = S.next(ui + 1, nxt);
        const char* nA = has_next ? (const char*)g.A + (size_t)nxt.pm * tstep : cA; const char* nB = has_next ? (const char*)g.Bt + (size_t)nxt.pn * tstep : cB;
        for (int t = 0; t < nt; t += 2) {
            const bool last = (t == nt - 2);
            const char* a1 = cA + (size_t)(t + 1) * kstep;
            const char* a2 = last ? nA : cA + (size_t)(t + 2) * kstep; const char* b2 = last ? nB : cB + (size_t)(t + 2) * kstep;
            const char* a3 = a2 + kstep; const char* b3 = b2 + kstep;
            if (last && has_next) S.a_ready(nxt);
            PG8_LDB(B0, 0, 0); PG8_SCHED; PG8_LDA(At, 0, 0); PG8_STAGE(PG8_SA(1, 1), a1 + hstep, voffA);
            PG8_WAIT_L(8); PG8_BAR; PG8_WAIT_L(0); PG8_MMA(0, 0, At, B0); PG8_BAR; PG8_SCHED;
            PG8_LDB(B1, 0, 1); PG8_STAGE(PG8_SB(0, 0), b2, voffB);
            PG8_BAR; PG8_WAIT_L(0); PG8_MMA(0, 1, At, B1); PG8_BAR;
            PG8_LDA(At, 0, 1); PG8_STAGE(PG8_SA(0, 0), a2, voffA);
            PG8_BAR; PG8_WAIT_L(0); PG8_MMA(1, 0, At, B0); PG8_BAR; PG8_SCHED;
            PG8_STAGE(PG8_SB(0, 1), b2 + hstep, voffB);
            PG8_WAIT_V(6); PG8_BAR; PG8_MMA(1, 1, At, B1); PG8_BAR;
            PG8_LDB(B0, 1, 0); PG8_SCHED; PG8_LDA(At, 1, 0); PG8_STAGE(PG8_SA(0, 1), a2 + hstep, voffA);
            PG8_WAIT_L(8); PG8_BAR; PG8_WAIT_L(0); PG8_MMA(0, 0, At, B0); PG8_BAR; PG8_SCHED;
            PG8_LDB(B1, 1, 1); PG8_STAGE(PG8_SB(1, 0), b3, voffB);
            PG8_BAR; PG8_WAIT_L(0); PG8_MMA(0, 1, At, B1); PG8_BAR;
            PG8_LDA(At, 1, 1); PG8_STAGE(PG8_SA(1, 0), a3, voffA);
            PG8_BAR; PG8_WAIT_L(0); PG8_MMA(1, 0, At, B0); PG8_BAR; PG8_SCHED;
            PG8_STAGE(PG8_SB(1, 1), b3 + hstep, voffB);
            PG8_WAIT_V(6); PG8_BAR; PG8_MMA(1, 1, At, B1); PG8_BAR;
        }
        PG8_STAMP();
        if constexpr (!Epi::AFTER_DRAIN) { E(acc, cur, wr, wc, fr, fq); S.done(cur); }
        PG8_STAMP();
        if (!has_next) break;
#pragma unroll
        for (int a = 0; a < 2; ++a)
#pragma unroll
            for (int b = 0; b < 2; ++b)
#pragma unroll
                for (int m = 0; m < 4; ++m)
#pragma unroll
                    for (int n = 0; n < 2; ++n) acc[a][b][m][n] = (f32x4){0.f, 0.f, 0.f, 0.f};
        cur = nxt; cA = nA; cB = nB; ++ui;
    }
    PG8_WAIT_V(0);
    if (wr == 0) PG8_BAR;
    PG8_BAR;
    if constexpr (Epi::AFTER_DRAIN) { E.fused(acc, cur, wr, wc, fr, fq, lds, wid, lane); S.done(cur); }
    PG8_STAMP();
    if (STAMP && wid == 0) { stamps[lane] = lane < nts ? (((unsigned long long)(unsigned)ts_hi << 32) | (unsigned)ts_lo) : 0ull;
        if (lane == 62) stamps[62] = rt_entry; if (lane == 63) stamps[63] = (unsigned long long)wall_clock64(); }
#undef PG8_STAMP
#undef PG8_SA
#undef PG8_SB
#undef PG8_STAGE
#undef PG8_LDA
#undef PG8_LDB
#undef PG8_MMA
#undef PG8_WAIT_V
#undef PG8_WAIT_L
#undef PG8_BAR
#undef PG8_SCHED
}
}

namespace att {
using bf16 = __hip_bfloat16;
constexpr int   D = 128, NW = 8, QBLK = 32, KVBLK = 64;
constexpr float SCALE = 0.088388347648318440f;
constexpr float THR = 8.f;
constexpr int SDEPTH = 2;
constexpr int LDQ = 1536, LDK = 1536, LDO = 1024;
constexpr size_t SHM_V = KVBLK * D * 2, SHM_K = KVBLK * D * 2, SHM_ATTN = 2 * SHM_V + 2 * SHM_K + NW * 64 * 4;
using bf16x8 = __attribute__((ext_vector_type(8))) short;
using s16x4  = __attribute__((ext_vector_type(4))) short;
using f32x16 = __attribute__((ext_vector_type(16))) float;
using f32x8  = __attribute__((ext_vector_type(8))) float;
using u32x4  = __attribute__((ext_vector_type(4))) unsigned;
#define KSWZ(row, colB) ((row) * 256 + ((colB) ^ (((row) & 7) << 4)))
#define SBAR() __builtin_amdgcn_sched_barrier(0)
__device__ __forceinline__ int crow(int r, int hi) { return (r & 3) + 8 * (r >> 2) + 4 * hi; }
__device__ __forceinline__ unsigned cvtpk(float lo, float hi) {
  unsigned r; asm volatile("v_cvt_pk_bf16_f32 %0, %1, %2" : "=v"(r) : "v"(lo), "v"(hi)); return r;
}
template <typename TIn> struct Stage;
template <> struct Stage<bf16>  { using T = bf16x8;
  __device__ static __forceinline__ T ld8(const bf16* p) { return *reinterpret_cast<const bf16x8*>(p); }
  __device__ static __forceinline__ bf16x8 tobf(T x) { return x; } };
template <> struct Stage<float> { using T = f32x8;
  __device__ static __forceinline__ T ld8(const float* p) { return *reinterpret_cast<const f32x8*>(p); }
  __device__ static __forceinline__ bf16x8 tobf(T x) {
    u32x4 w = {cvtpk(x[0], x[1]), cvtpk(x[2], x[3]), cvtpk(x[4], x[5]), cvtpk(x[6], x[7])}; return *reinterpret_cast<bf16x8*>(&w); } };

__device__ __forceinline__ void partialSM(f32x16& p0, f32x16& p1, float& m_reg, float& mn, float& alpha) {
  constexpr float C = SCALE * 1.4426950408889634f;
  float pmax = p0[0]; for (int r = 1; r < 16; ++r) pmax = fmaxf(pmax, p0[r]); for (int r = 0; r < 16; ++r) pmax = fmaxf(pmax, p1[r]);
  { auto rr = __builtin_amdgcn_permlane32_swap(__float_as_uint(pmax), __float_as_uint(pmax), false, false);
    pmax = fmaxf(__uint_as_float(rr[0]), __uint_as_float(rr[1])); }
  if (__builtin_expect(__all(pmax - m_reg <= THR / SCALE), 1)) { mn = m_reg; alpha = 1.f; }
  else { mn = fmaxf(m_reg, pmax); alpha = __builtin_amdgcn_exp2f((m_reg - mn) * C); m_reg = mn; }
  float mnC = -mn * C;
  for (int r = 0; r < 16; ++r) p0[r] = fmaf(p0[r], C, mnC); for (int r = 0; r < 16; ++r) p1[r] = fmaf(p1[r], C, mnC);
  for (int r = 0; r < 16; ++r) p0[r] = __builtin_amdgcn_exp2f(p0[r]);
}
__device__ __forceinline__ void finishSM(f32x16& p0, f32x16& p1, float alpha, float& l_reg, bf16x8& pa0, bf16x8& pa1, bf16x8& pa2, bf16x8& pa3) {
  for (int r = 0; r < 16; ++r) p1[r] = __builtin_amdgcn_exp2f(p1[r]);
  float ps = 0; for (int r = 0; r < 16; ++r) ps += p0[r]; for (int r = 0; r < 16; ++r) ps += p1[r];
  { auto rr = __builtin_amdgcn_permlane32_swap(__float_as_uint(ps), __float_as_uint(ps), false, false);
    ps = __uint_as_float(rr[0]) + __uint_as_float(rr[1]); }
  l_reg = l_reg * alpha + ps;
#define PK4(P, BASE, OUT) do { unsigned a0 = cvtpk(P[BASE + 0], P[BASE + 1]), a1 = cvtpk(P[BASE + 2], P[BASE + 3]);   \
    unsigned b0 = cvtpk(P[BASE + 4], P[BASE + 5]), b1 = cvtpk(P[BASE + 6], P[BASE + 7]);                              \
    auto r0 = __builtin_amdgcn_permlane32_swap(a0, b0, false, false); auto r1 = __builtin_amdgcn_permlane32_swap(a1, b1, false, false); \
    u32x4 w = {r0[0], r1[0], r0[1], r1[1]}; OUT = *reinterpret_cast<bf16x8*>(&w); } while (0)
  PK4(p0, 0, pa0); PK4(p0, 8, pa1); PK4(p1, 0, pa2); PK4(p1, 8, pa3);
#undef PK4
}
__device__ __forceinline__ void qkt(f32x16& p0, f32x16& p1, const bf16* Ks, const bf16x8* qr, int r32, int hi) {
  p0 = f32x16{}; p1 = f32x16{};
  for (int d0 = 0; d0 < 8; ++d0) { int cb = (d0 * 16 + hi * 8) * 2;
    bf16x8 b0 = *reinterpret_cast<const bf16x8*>((const char*)Ks + KSWZ(r32, cb));
    bf16x8 b1 = *reinterpret_cast<const bf16x8*>((const char*)Ks + KSWZ(32 + r32, cb));
    p0 = __builtin_amdgcn_mfma_f32_32x32x16_bf16(b0, qr[d0], p0, 0, 0, 0);
    p1 = __builtin_amdgcn_mfma_f32_32x32x16_bf16(b1, qr[d0], p1, 0, 0, 0); }
}
__device__ __forceinline__ int v_st(int k, int c) { const int kk = (k & ~0xC) | ((k & 4) << 1) | ((k & 8) >> 1); return ((kk >> 3) * 4 + (c >> 5)) * 512 + ((kk & 7) * 32 + (c & 31)) * 2; }
__device__ __forceinline__ int v_rd_base(int lane) { return ((lane & 3) << 3) | (((lane >> 2) & 3) << 6) | (((lane >> 4) & 1) << 5) | (((lane >> 5) & 1) << 8); }
constexpr int v_rd_off(int d0, int ks, int half) { return d0 * 512 + ks * 4096 + half * 2048; }
template <int OFF> __device__ __forceinline__ s16x4 tr_read(int vb) {
  s16x4 r; asm volatile("ds_read_b64_tr_b16 %0, %1 offset:%2" : "=&v"(r) : "v"(vb), "i"(OFF) : "memory"); return r;
}
template <int D0> __device__ __forceinline__ void pv_one(f32x16& od, int vb, bf16x8 pa0, bf16x8 pa1, bf16x8 pa2, bf16x8 pa3) {
  const s16x4 l0 = tr_read<v_rd_off(D0, 0, 0)>(vb), h0 = tr_read<v_rd_off(D0, 0, 1)>(vb), l1 = tr_read<v_rd_off(D0, 1, 0)>(vb), h1 = tr_read<v_rd_off(D0, 1, 1)>(vb);
  const s16x4 l2 = tr_read<v_rd_off(D0, 2, 0)>(vb), h2 = tr_read<v_rd_off(D0, 2, 1)>(vb), l3 = tr_read<v_rd_off(D0, 3, 0)>(vb), h3 = tr_read<v_rd_off(D0, 3, 1)>(vb);
  asm volatile("s_waitcnt lgkmcnt(0)" ::: "memory"); SBAR();
#define PK(L, H) (bf16x8){L[0], L[1], L[2], L[3], H[0], H[1], H[2], H[3]}
  od = __builtin_amdgcn_mfma_f32_32x32x16_bf16(pa0, PK(l0, h0), od, 0, 0, 0);
  od = __builtin_amdgcn_mfma_f32_32x32x16_bf16(pa1, PK(l1, h1), od, 0, 0, 0);
  od = __builtin_amdgcn_mfma_f32_32x32x16_bf16(pa2, PK(l2, h2), od, 0, 0, 0);
  od = __builtin_amdgcn_mfma_f32_32x32x16_bf16(pa3, PK(l3, h3), od, 0, 0, 0);
#undef PK
}
__device__ __forceinline__ void pv_d0(f32x16* o, int vb, bf16x8 pa0, bf16x8 pa1, bf16x8 pa2, bf16x8 pa3) {
  pv_one<0>(o[0], vb, pa0, pa1, pa2, pa3); pv_one<1>(o[1], vb, pa0, pa1, pa2, pa3); pv_one<2>(o[2], vb, pa0, pa1, pa2, pa3); pv_one<3>(o[3], vb, pa0, pa1, pa2, pa3);
}

template <typename TQ>
__device__ __forceinline__ void attn_dense_body(const TQ* __restrict__ Qb, const bf16* __restrict__ Kh, const bf16* __restrict__ Vh,
                                                unsigned short* __restrict__ Ob, int seq, char* lds) {
  using St = Stage<bf16>; using SQ = Stage<TQ>;
  const int tid = otid(), wid = tid >> 6, lane = tid & 63, r32 = lane & 31, hi = lane >> 5;
  bf16* V_lds = (bf16*)lds; bf16* K_lds = (bf16*)(lds + 2 * SHM_V);
  float* ws = (float*)(lds + 2 * SHM_V + 2 * SHM_K) + wid * 64; float* li_l = ws; float* al_l = ws + 32;
  float m_reg = -1e30f, l_reg = 0; f32x16 o[4] = {}; bf16x8 qr[8];
  const TQ* Qw = Qb + (long)(wid * QBLK + r32) * LDQ + hi * 8;
#pragma unroll
  for (int d0 = 0; d0 < 8; ++d0) qr[d0] = SQ::tobf(SQ::ld8(Qw + d0 * 16));
  const int sr = tid >> 4, sc = (tid & 15) * 8, vst0 = v_st(sr, sc), vst1 = v_st(32 + sr, sc);
  const int vb0 = (int)(uintptr_t)V_lds + v_rd_base(lane);
  struct { typename St::T vs0, vs1, ks0, ks1; } sr_[SDEPTH];
#define SLOAD(i, k0) do { sr_[i].vs0 = St::ld8(&Vh[(long)((k0) + sr) * LDK + sc]); sr_[i].vs1 = St::ld8(&Vh[(long)((k0) + 32 + sr) * LDK + sc]); \
    sr_[i].ks0 = St::ld8(&Kh[(long)((k0) + sr) * LDK + sc]); sr_[i].ks1 = St::ld8(&Kh[(long)((k0) + 32 + sr) * LDK + sc]); } while (0)
#define SWRITE(b, i) do { *(bf16x8*)((char*)V_lds + (b) * SHM_V + vst0) = St::tobf(sr_[i].vs0);          \
    *(bf16x8*)((char*)V_lds + (b) * SHM_V + vst1) = St::tobf(sr_[i].vs1); int kc = sc * 2;               \
    *(bf16x8*)((char*)K_lds + (b) * SHM_K + KSWZ(sr, kc)) = St::tobf(sr_[i].ks0);                       \
    *(bf16x8*)((char*)K_lds + (b) * SHM_K + KSWZ(32 + sr, kc)) = St::tobf(sr_[i].ks1); } while (0)
#define SWAIT() do { if constexpr (SDEPTH == 2) asm volatile("s_waitcnt vmcnt(4)" ::: "memory"); else asm volatile("s_waitcnt vmcnt(0)" ::: "memory"); } while (0)
#define RESC(a) do { if (__any((a) < 1.f)) { if (hi == 0) al_l[r32] = (a); asm volatile("s_waitcnt lgkmcnt(0)" ::: "memory"); \
    for (int d = 0; d < 4; ++d) for (int r = 0; r < 16; ++r) o[d][r] *= al_l[crow(r, hi)]; } } while (0)
  f32x16 pA0, pA1, pB0, pB1; float mnA, mnB, alA, alB; bf16x8 pa0, pa1, pa2, pa3; const int NT = seq / KVBLK;
  constexpr int SE = 0, SO = SDEPTH - 1;
  SLOAD(SE, 0); asm volatile("s_waitcnt vmcnt(0)" ::: "memory"); SWRITE(0, SE); __syncthreads();
  qkt(pA0, pA1, K_lds, qr, r32, hi); partialSM(pA0, pA1, m_reg, mnA, alA);
  SLOAD(SO, KVBLK); if constexpr (SDEPTH == 2) { if (2 < NT) SLOAD(SE, 2 * KVBLK); }
  SWAIT(); SWRITE(1, SO); __syncthreads();
  for (int j = 1; j + 1 < NT; j += 2) {
    SBAR(); qkt(pB0, pB1, (bf16*)((char*)K_lds + SHM_K), qr, r32, hi);
    finishSM(pA0, pA1, alA, l_reg, pa0, pa1, pa2, pa3); SBAR();
    SLOAD(SO, (j + SDEPTH) * KVBLK); SBAR();
    pv_d0(o, vb0, pa0, pa1, pa2, pa3); partialSM(pB0, pB1, m_reg, mnB, alB);
    __syncthreads(); SWAIT(); SWRITE(0, SE);
    RESC(alB); __syncthreads();
    SBAR(); qkt(pA0, pA1, K_lds, qr, r32, hi);
    finishSM(pB0, pB1, alB, l_reg, pa0, pa1, pa2, pa3); SBAR();
    if (SDEPTH == 1 || j + 3 < NT) SLOAD(SE, (j + 1 + SDEPTH) * KVBLK); SBAR();
    pv_d0(o, vb0 + (int)SHM_V, pa0, pa1, pa2, pa3); partialSM(pA0, pA1, m_reg, mnA, alA);
    __syncthreads(); SWAIT(); SWRITE(1, SO);
    RESC(alA); __syncthreads();
  }
  SBAR(); qkt(pB0, pB1, (bf16*)((char*)K_lds + SHM_K), qr, r32, hi);
  finishSM(pA0, pA1, alA, l_reg, pa0, pa1, pa2, pa3); SBAR();
  pv_d0(o, vb0, pa0, pa1, pa2, pa3); partialSM(pB0, pB1, m_reg, mnB, alB);
  __syncthreads(); RESC(alB);
  finishSM(pB0, pB1, alB, l_reg, pa0, pa1, pa2, pa3); SBAR();
  pv_d0(o, vb0 + (int)SHM_V, pa0, pa1, pa2, pa3);
  if (hi == 0) li_l[r32] = l_reg; asm volatile("s_waitcnt lgkmcnt(0)" ::: "memory");
  float rli[16];
#pragma unroll
  for (int r = 0; r < 16; ++r) rli[r] = __builtin_amdgcn_rcpf(li_l[crow(r, hi)]);
  unsigned short* Ow = Ob + (long)(wid * QBLK) * LDO;
#pragma unroll
  for (int r = 0; r < 16; ++r) { int orow = crow(r, hi);
    for (int d0 = 0; d0 < 4; ++d0) Ow[(long)orow * LDO + d0 * 32 + r32] = (unsigned short)(cvtpk(o[d0][r] * rli[r], 0.f) & 0xffffu); }
#undef SLOAD
#undef SWRITE
#undef SWAIT
#undef RESC
}
}

using pg8::bf16_t; using pg8::bf16x8; using pg8::f32x4; using pg8::u32x4; using pg8::Unit;
typedef unsigned u32x2 __attribute__((ext_vector_type(2)));
constexpr int NB = 8, RPB = 2304  , T = NB * RPB, NIN = 12800;
constexpr size_t AL(size_t x) { return (x + 255) & ~(size_t)255; }
constexpr size_t SZ_TD   = (size_t)T * 1024 * 2;
constexpr size_t WS_MODS = 0;
constexpr size_t WS_HIDF = WS_MODS + AL((size_t)2 * 9 * 6144 * 4);
constexpr size_t WS_XC   = WS_HIDF + AL((size_t)2 * 2304 * 64 * 4);
constexpr size_t WS_WIN  = WS_XC + AL((size_t)8 * 256 * 1024 * 4);
constexpr size_t WS_WBR  = WS_WIN + (size_t)NIN * 1024 * 2;
constexpr size_t WS_WOUT = WS_WBR + (size_t)3 * 1024 * 1024 * 2;
constexpr size_t WS_WM1  = WS_WOUT + (size_t)1024 * 1024 * 2;
constexpr size_t WS_WM2  = WS_WM1 + (size_t)4096 * 1024 * 2;
constexpr size_t WS_H    = WS_WM2 + (size_t)4096 * 1024 * 2;
constexpr size_t WS_ARENA = WS_H + SZ_TD;
constexpr size_t WS_ATT = WS_ARENA, WS_HG = WS_ARENA + SZ_TD, WS_S = WS_ARENA + 2 * SZ_TD;
constexpr size_t WS_QKV = WS_S;
constexpr size_t WS_ZH  = WS_S;
constexpr size_t WS_OFB = WS_S + (size_t)T * 2560 * 2;
constexpr size_t WS_UT  = WS_S;
constexpr size_t WS_G = WS_S, WS_HY = WS_S + SZ_TD, WS_MRG = WS_S + 2 * SZ_TD;
constexpr size_t WS_HID4 = WS_ARENA;
constexpr size_t WS_QS  = AL(WS_OFB + (size_t)2 * T * 512 * 2);
constexpr size_t WS_ST0 = WS_QS + (size_t)64 * 1152 * 128 * 2;
constexpr size_t WS_CTL = AL(WS_ST0 + (size_t)64 * 2 * 64 * 128 * 4);
constexpr size_t WS_END = WS_CTL + 16384;
static_assert(WS_END <= (size_t)333735424, "workspace");
constexpr int LDS_BYTES = 147456;

struct Params {
    const float *x, *c, *ctx, *c_ctx, *ada_w, *ada_b, *norm1_g, *norm2_g, *w_in, *q_norm_g, *k_norm_g, *hg_lb_raw, *hg_norm_g, *hy_short_w, *hy_short_b,
        *hy_filt_w1, *hy_filt_b1, *hy_filt_w2, *hy_filt_b2, *hy_filt_w3, *hy_freq, *hy_bias, *w_branch, *w_out, *w_mlp1, *w_mlp2;
    float* out; unsigned char* ws;
};
typedef const __attribute__((address_space(4))) Params* PP;

__device__ __forceinline__ unsigned pk2(float lo, float hi) { unsigned r; asm volatile("v_cvt_pk_bf16_f32 %0, %1, %2" : "=v"(r) : "v"(lo), "v"(hi)); return r; }
__device__ __forceinline__ bf16_t f2bf(float x) { return (bf16_t)(pk2(x, 0.f) & 0xffffu); }
__device__ __forceinline__ bf16_t f2bf_sw(float x) { unsigned u = __float_as_uint(x); u += 0x7fffu + ((u >> 16) & 1u); return (bf16_t)(u >> 16); }
__device__ __forceinline__ float bf2f(bf16_t v) { return __uint_as_float(((unsigned)v) << 16); }
__device__ __forceinline__ float wave_sum(float v) {
#pragma unroll
    for (int o = 32; o > 0; o >>= 1) v += __shfl_xor(v, o);
    return v;
}

#define LAS __attribute__((address_space(3)))
#define XB_TMO      128
#define XB_XCNT(j)  (256  + 64 * (j))
#define XB_XSUB(j)  (1280 + 64 * (j))
#define XB_XGEN(j)  (2304 + 64 * (j))
#define XB_TOP      3328
#define XB_TOPGEN   3392
#define XCD_BAR_WORDS 3456
#define XB_SPIN_CAP (1u << 18)

__device__ __forceinline__ unsigned xb_ld(unsigned* p)              { return __hip_atomic_load(p, __ATOMIC_RELAXED, __HIP_MEMORY_SCOPE_AGENT); }
__device__ __forceinline__ unsigned xb_add(unsigned* p, unsigned v) { return __hip_atomic_fetch_add(p, v, __ATOMIC_RELAXED, __HIP_MEMORY_SCOPE_AGENT); }
__device__ __forceinline__ unsigned xb_xcc_id() { return (unsigned)__builtin_amdgcn_s_getreg((3 << 11) | 20) & 0xFu; }
#define XB_SPIN(cond, bar) do { unsigned _sp = 0; while (cond) { __builtin_amdgcn_s_sleep(1); \
    if ((++_sp & 255u) == 0u) { if (xb_ld(&(bar)[XB_TMO])) break; if (_sp > XB_SPIN_CAP) { atomicAdd(&(bar)[XB_TMO], 1u); break; } } } } while (0)

struct XcdBarrier {
    unsigned* bar; unsigned x;
    volatile LAS unsigned* st;
};

__device__ __forceinline__ XcdBarrier xcd_barrier_post(unsigned* bar, volatile LAS unsigned* st) {
    XcdBarrier b; b.bar = bar; b.x = xb_xcc_id(); b.st = st;
    if (threadIdx.x == 0) (void)xb_add(&bar[XB_XCNT(b.x)], 1u);
    return b;
}
__device__ __forceinline__ void xcd_barrier_complete(unsigned* bar, unsigned x, unsigned& nloc, unsigned& nx) {
    const unsigned G = gridDim.x * gridDim.y * gridDim.z;
    unsigned sum, cnt, mine, sp = 0u;
    for (;;) {
        sum = 0u; cnt = 0u; mine = 0u;
#pragma unroll
        for (unsigned j = 0; j < 16; ++j) { const unsigned c = xb_ld(&bar[XB_XCNT(j)]); sum += c; cnt += (c > 0u) ? 1u : 0u; mine = (j == x) ? c : mine; }
        if (sum == G) break;
        __builtin_amdgcn_s_sleep(1);
        if ((++sp & 255u) == 0u) { if (xb_ld(&bar[XB_TMO])) break; if (sp > XB_SPIN_CAP) { atomicAdd(&bar[XB_TMO], 1u); break; } }
    }
    nloc = mine > 0u ? mine : 1u; nx = cnt > 0u ? cnt : 1u;
}

__device__ __forceinline__ void xcd_barrier(const XcdBarrier& b) {
    asm volatile("s_waitcnt vmcnt(0)" ::: "memory");
    __syncthreads();
    if (threadIdx.x == 0) {
        unsigned* bar = b.bar;
        __builtin_amdgcn_s_waitcnt(0);
        unsigned nloc = b.st[0], nx = b.st[1];
        if (nloc == 0u) { xcd_barrier_complete(bar, b.x, nloc, nx); b.st[0] = nloc; b.st[1] = nx; }
        const unsigned old = xb_add(&bar[XB_XSUB(b.x)], 1u);
        const unsigned gen = old / nloc;
        if (old + 1u == (gen + 1u) * nloc) {
            __builtin_amdgcn_fence(__ATOMIC_RELEASE, "agent");
            asm volatile("s_waitcnt vmcnt(0)" ::: "memory");
            const unsigned og = xb_add(&bar[XB_TOP], 1u);
            const unsigned tg = og / nx;
            if (og + 1u == (tg + 1u) * nx) xb_add(&bar[XB_TOPGEN], 1u);
            else XB_SPIN(xb_ld(&bar[XB_TOPGEN]) == tg, bar);
            __builtin_amdgcn_fence(__ATOMIC_ACQUIRE, "agent");
            xb_add(&bar[XB_XGEN(b.x)], 1u);
            asm volatile("s_waitcnt vmcnt(0)" ::: "memory");
        } else {
            XB_SPIN(xb_ld(&bar[XB_XGEN(b.x)]) == gen, bar);
            __builtin_amdgcn_fence(__ATOMIC_ACQUIRE, "agent");
            asm volatile("s_waitcnt vmcnt(0)" ::: "memory");
        }
    }
    __syncthreads();
}

struct Sched {
    int nM, nN, nwg, G, c, skip;
    __device__ __forceinline__ void init(int nM_, int nN_, int G_, int c_, int skip_) { nM = nM_; nN = nN_; nwg = nM_ * nN_; G = G_; c = c_; skip = skip_; }
    __device__ __forceinline__ bool next(int i, Unit& u) const {
        const long L = (long)i * G + c; if (L >= nwg) return false;
        int wgid = (int)L; { const int q = nwg / 8, r = nwg % 8, xcd = wgid % 8, off = wgid / 8; wgid = (xcd < r ? xcd * (q + 1) : r * (q + 1) + (xcd - r) * q) + off; }
        const int nig = 8 * nN, gid = wgid / nig, fm = gid * 8, gsz = (nM - fm) < 8 ? (nM - fm) : 8;
        u.pm = fm + ((wgid % nig) % gsz); u.pn = (wgid % nig) / gsz;
        if (skip == 1) u.pm += u.pm / 8 + 1;
        if (skip == 2) u.pn += u.pn / 8 + 1;
        return true;
    }
    __device__ __forceinline__ void a_ready(const Unit&) const {}
    __device__ __forceinline__ void done(const Unit&) const {}
};

template <int ACT  > struct EpiBf {
    static constexpr bool PERM = true, AFTER_DRAIN = false;
    bf16_t* O; int ldc;
    __device__ __forceinline__ void operator()(const f32x4 (&acc)[2][2][4][2], const Unit& u, int wr, int wc, int fr, int fq) const {
        const int row0 = u.pm * 256 + wr * 64 + fr, col0 = u.pn * 256 + wc * 32 + 8 * fq;
#pragma unroll
        for (int ai = 0; ai < 2; ++ai)
#pragma unroll
            for (int m = 0; m < 4; ++m) { bf16_t* rowp = O + (size_t)(row0 + ai * 128 + m * 16) * ldc + col0;
#pragma unroll
                for (int bj = 0; bj < 2; ++bj) { f32x4 v0 = acc[ai][bj][m][0], v1 = acc[ai][bj][m][1];
                    if (ACT == 0) {
#pragma unroll
                        for (int j = 0; j < 4; ++j) { v0[j] = v0[j] + 0.f; v1[j] = v1[j] + 0.f; } }
                    if (ACT == 1) {
#pragma unroll
                        for (int j = 0; j < 4; ++j) { v0[j] = __builtin_amdgcn_rcpf(1.f + __expf(-v0[j])) + 0.f; v1[j] = __builtin_amdgcn_rcpf(1.f + __expf(-v1[j])) + 0.f; } }
                    if (ACT == 2) {
#pragma unroll
                        for (int j = 0; j < 4; ++j) { float a = fmaxf(v0[j], 0.f), b = fmaxf(v1[j], 0.f); v0[j] = a * a; v1[j] = b * b; } }
                    u32x4 w; w.x = pk2(v0[0], v0[1]); w.y = pk2(v0[2], v0[3]); w.z = pk2(v1[0], v1[1]); w.w = pk2(v1[2], v1[3]);
                    *(u32x4*)(rowp + bj * 128) = w; } }
    }
};
struct EpiMerge {
    static constexpr bool PERM = true, AFTER_DRAIN = false;
    const bf16_t* G; bf16_t* MRG; int first;
    __device__ __forceinline__ void operator()(const f32x4 (&acc)[2][2][4][2], const Unit& u, int wr, int wc, int fr, int fq) const {
        const int row0 = u.pm * 256 + wr * 64 + fr, col0 = u.pn * 256 + wc * 32 + 8 * fq;
#pragma unroll
        for (int ai = 0; ai < 2; ++ai)
#pragma unroll
            for (int m = 0; m < 4; ++m) { const size_t ro = (size_t)(row0 + ai * 128 + m * 16) * 1024 + col0;
#pragma unroll
                for (int bj = 0; bj < 2; ++bj) {
                    const u32x4 g = *(const u32x4*)(G + ro + bj * 128);
                    u32x4 o = {0u, 0u, 0u, 0u}; if (!first) o = *(const u32x4*)(MRG + ro + bj * 128);
                    float r[8];
#pragma unroll
                    for (int j = 0; j < 4; ++j) {
                        const float a0 = (j < 2 ? acc[ai][bj][m][0][2 * j] : acc[ai][bj][m][1][2 * j - 4]), a1 = (j < 2 ? acc[ai][bj][m][0][2 * j + 1] : acc[ai][bj][m][1][2 * j - 3]);
                        r[2 * j]     = __uint_as_float(o[j] << 16) + __uint_as_float(g[j] << 16) * a0;
                        r[2 * j + 1] = __uint_as_float(o[j] & 0xffff0000u) + __uint_as_float(g[j] & 0xffff0000u) * a1; }
                    u32x4 w; w.x = pk2(r[0], r[1]); w.y = pk2(r[2], r[3]); w.z = pk2(r[4], r[5]); w.w = pk2(r[6], r[7]);
                    *(u32x4*)(MRG + ro + bj * 128) = w; } }
    }
};
struct EpiResid {
    static constexpr bool PERM = false, AFTER_DRAIN = false;
    const float* in_lat; const float* in_ctx; float* x_lat; float* x_ctx; const float* mods_l; int goff;
    __device__ __forceinline__ void operator()(const f32x4 (&acc)[2][2][4][2], const Unit& u, int wr, int wc, int fr, int fq) const {
        const int b = u.pm / 9, pt = u.pm % 9;
        float* xp; const float* xi_p; const float* gate;
        if (pt == 0) { const size_t o = (size_t)b * 256 * 1024; xp = x_ctx + o; xi_p = in_ctx + o; gate = mods_l + 8 * 6144 + goff; }
        else { const size_t o = ((size_t)b * 2048 + (size_t)(pt - 1) * 256) * 1024; xp = x_lat + o; xi_p = in_lat + o; gate = mods_l + b * 6144 + goff; }
        const int lr0 = wr * 64 + fr, col0 = u.pn * 256 + wc * 32 + 4 * fq;
#pragma unroll
        for (int ai = 0; ai < 2; ++ai)
#pragma unroll
            for (int m = 0; m < 4; ++m) { const unsigned ro = (unsigned)(lr0 + ai * 128 + m * 16) * 1024u + (unsigned)col0;
                __builtin_amdgcn_sched_barrier(0);
#pragma unroll
                for (int bj = 0; bj < 2; ++bj)
#pragma unroll
                    for (int n = 0; n < 2; ++n) { const f32x4 xi = *(const f32x4*)(xi_p + ro + bj * 128 + n * 16); const f32x4 gq = *(const f32x4*)(gate + col0 + bj * 128 + n * 16);
                        *(f32x4*)(xp + ro + bj * 128 + n * 16) = xi + gq * acc[ai][bj][m][n]; } }
    }
};

template <class Epi>
__device__ __forceinline__ void run_gemm(unsigned char* smem, const bf16_t* A, const bf16_t* Bt, int nM, int nN, int K, int rot, int skip, const Epi& E) {
    pg8::Gemm g{A, Bt, nM * 256, nN * 256, K};
    Sched S; S.init(nM, nN, (int)gridDim.x, (int)((blockIdx.x + (unsigned)rot) % gridDim.x), skip);
    pg8::gemm_phase<Epi, Sched, false>((PG8_LAS unsigned char*)smem, g, S, E, nullptr);
}

__device__ __forceinline__ int mapcol(int n) {
    if (n < 1536 || n >= 6656) return n;
    const int x = n - 1536, hh = x / 2560, y = x % 2560, role = y / 512, j = y % 512;
    return 1536 + role * 1024 + hh * 512 + j;
}
__device__ __forceinline__ void conv_tile_desc(PP p, int l, int g, const float*& src, int& ld, int& col0, int& K, int& k0, int& drow0, bf16_t*& dst) {
    if (g < 3200) { const int nt = g >> 4, kt = g & 15; src = p->w_in + (size_t)l * 1024 * NIN; ld = NIN; drow0 = nt * 64; col0 = mapcol(drow0); K = 1024; k0 = kt * 64; dst = (bf16_t*)(p->ws + WS_WIN); }
    else if (g < 3968) { const int q = g - 3200, i = q >> 8, r = q & 255, nt = r >> 4, kt = r & 15; src = p->w_branch + ((size_t)l * 3 + i) * 1024 * 1024; ld = 1024; drow0 = nt * 64; col0 = drow0; K = 1024; k0 = kt * 64; dst = (bf16_t*)(p->ws + WS_WBR) + (size_t)i * 1024 * 1024; }
    else if (g < 4224) { const int q = g - 3968, nt = q >> 4, kt = q & 15; src = p->w_out + (size_t)l * 1024 * 1024; ld = 1024; drow0 = nt * 64; col0 = drow0; K = 1024; k0 = kt * 64; dst = (bf16_t*)(p->ws + WS_WOUT); }
    else if (g < 5248) { const int q = g - 4224, nt = q >> 4, kt = q & 15; src = p->w_mlp1 + (size_t)l * 1024 * 4096; ld = 4096; drow0 = nt * 64; col0 = drow0; K = 1024; k0 = kt * 64; dst = (bf16_t*)(p->ws + WS_WM1); }
    else { const int q = g - 5248, nt = q >> 6, kt = q & 63; src = p->w_mlp2 + (size_t)l * 4096 * 1024; ld = 1024; drow0 = nt * 64; col0 = drow0; K = 4096; k0 = kt * 64; dst = (bf16_t*)(p->ws + WS_WM2); }
}
__device__ void conv_weights(PP p, int l, unsigned char* smem, int g_lo, int g_hi, int b_lo) {
    float* tiles = (float*)smem;
    const int tid = otid();
    if ((int)blockIdx.x < b_lo) return;
    for (int g0 = g_lo + ((int)blockIdx.x - b_lo) * 4; g0 < g_hi; g0 += ((int)gridDim.x - b_lo) * 4) {
        float4 a[4], b[4];
#pragma unroll
        for (int q = 0; q < 4; ++q) { const int g = g0 + q; if (g < g_hi) {
            const float* src; int ld, col0, K, k0, drow0; bf16_t* dst; conv_tile_desc(p, l, g, src, ld, col0, K, k0, drow0, dst);
            const int kk = tid >> 4, n4 = (tid & 15) * 4;
            a[q] = *(const float4*)(src + (size_t)(k0 + kk) * ld + col0 + n4); b[q] = *(const float4*)(src + (size_t)(k0 + kk + 32) * ld + col0 + n4); } }
#pragma unroll
        for (int q = 0; q < 4; ++q) { if (g0 + q < g_hi) { const int kk = tid >> 4, n4 = (tid & 15) * 4; float* tile = tiles + q * 64 * 65;
            float* t0 = tile + kk * 65 + n4; t0[0] = a[q].x; t0[1] = a[q].y; t0[2] = a[q].z; t0[3] = a[q].w;
            float* t1 = tile + (kk + 32) * 65 + n4; t1[0] = b[q].x; t1[1] = b[q].y; t1[2] = b[q].z; t1[3] = b[q].w; } }
        __syncthreads();
#pragma unroll
        for (int q = 0; q < 4; ++q) { const int g = g0 + q; if (g < g_hi) {
            const float* src; int ld, col0, K, k0, drow0; bf16_t* dst; conv_tile_desc(p, l, g, src, ld, col0, K, k0, drow0, dst);
            const float* tile = tiles + q * 64 * 65; const int n = tid >> 3, k8 = (tid & 7) * 8; float v[8];
#pragma unroll
            for (int j = 0; j < 8; ++j) v[j] = tile[(k8 + j) * 65 + n];
            u32x4 w; w.x = pk2(v[0], v[1]); w.y = pk2(v[2], v[3]); w.z = pk2(v[4], v[5]); w.w = pk2(v[6], v[7]);
            *(u32x4*)(dst + (size_t)(drow0 + n) * K + k0 + k8) = w; } }
        __syncthreads();
    }
}
__device__ void prep_hid(PP p) {
    const int lane = otid() & 63, gw = blockIdx.x * 8 + (otid() >> 6), nw = gridDim.x * 8;
    float* HID = (float*)(p->ws + WS_HIDF);
    for (int item = gw; item < 2 * 2304; item += nw) {
        const int l = item / 2304, r = item % 2304; int n, i; if (r < 2048) { n = 2048; i = r; } else { n = 256; i = r - 2048; }
        const float ti = (float)i / (float)(n - 1), wi = (6.283185307179586f / (float)n) * (float)i;
        const float* w1 = p->hy_filt_w1 + (size_t)l * 33 * 64;
        float acc = p->hy_filt_b1[l * 64 + lane] + ti * w1[lane];
        for (int m = 0; m < 16; ++m) { const float fm = 1e-4f + (float)m * ((15.f - 1e-4f) / 15.f); float s, c; sincosf(fm * wi, &s, &c);
            acc += c * w1[(1 + m) * 64 + lane] - s * w1[(17 + m) * 64 + lane]; }
        const float h1 = sinf(p->hy_freq[(l * 2 + 0) * 64 + lane] * acc);
        const float* w2 = p->hy_filt_w2 + (size_t)l * 64 * 64;
        float acc2 = p->hy_filt_b2[l * 64 + lane];
        for (int jj = 0; jj < 64; ++jj) acc2 += __shfl(h1, jj) * w2[jj * 64 + lane];
        HID[((size_t)l * 2304 + r) * 64 + lane] = sinf(p->hy_freq[(l * 2 + 1) * 64 + lane] * acc2);
    }
}
__device__ void prep_mods(PP p, unsigned char* smem) {
    float* s = (float*)smem; float* part = s + 9 * 1024; float* MODS = (float*)(p->ws + WS_MODS);
    const int tid = otid();
    for (int bi = blockIdx.x; bi < 192; bi += gridDim.x) {
        __syncthreads();
        for (int e = tid; e < 9 * 1024; e += 512) { const int j = e >> 10, d = e & 1023; const float cv = (j < 8) ? p->c[j * 1024 + d] : p->c_ctx[d]; s[e] = cv / (1.f + expf(-cv)); }
        __syncthreads();
        const int l = bi / 96, e0 = (bi % 96) * 64, ec = tid & 63, ds = tid >> 6;
        float acc[9];
#pragma unroll
        for (int j = 0; j < 9; ++j) acc[j] = 0.f;
        const float* w = p->ada_w + ((size_t)l * 1024 + ds * 128) * 6144 + e0 + ec;
#pragma unroll 16
        for (int d = 0; d < 128; ++d) { const float wv = w[(size_t)d * 6144];
#pragma unroll
            for (int j = 0; j < 9; ++j) acc[j] += s[j * 1024 + ds * 128 + d] * wv; }
#pragma unroll
        for (int j = 0; j < 9; ++j) part[(ds * 9 + j) * 64 + ec] = acc[j];
        __syncthreads();
        for (int o = tid; o < 576; o += 512) { const int j = o >> 6, e2 = o & 63; float sum = 0.f;
            for (int d2 = 0; d2 < 8; ++d2) sum += part[(d2 * 9 + j) * 64 + e2];
            MODS[((size_t)l * 9 + j) * 6144 + e0 + e2] = sum + p->ada_b[l * 6144 + e0 + e2]; }
    }
    __syncthreads();
}

__device__ void phase_norm(PP p, int l, int which, const float* xl, const float* xc) {
    const int lane = otid() & 63, gw = blockIdx.x * 8 + (otid() >> 6), nw = gridDim.x * 8;
    const float* g = (which ? p->norm2_g : p->norm1_g) + l * 1024;
    const int shoff = which ? 3072 : 0, scoff = which ? 4096 : 1024;
    const float* MODS = (const float*)(p->ws + WS_MODS);
    bf16_t* H = (bf16_t*)(p->ws + WS_H);
    for (int r = gw; r < T; r += nw) {
        const int b = r / RPB, pp = r % RPB;
        if (which && l && pp < 256) continue;
        const float* src = pp < 256 ? xc + ((size_t)b * 256 + pp) * 1024 : xl + ((size_t)b * 2048 + (pp - 256)) * 1024;
        const float* md = MODS + ((size_t)l * 9 + (pp < 256 ? 8 : b)) * 6144;
        float4 v[4]; float ss = 0.f;
#pragma unroll
        for (int i = 0; i < 4; ++i) { v[i] = *(const float4*)(src + i * 256 + lane * 4); ss += v[i].x * v[i].x + v[i].y * v[i].y + v[i].z * v[i].z + v[i].w * v[i].w; }
        ss = wave_sum(ss); const float rstd = 1.0f / sqrtf(ss * (1.f / 1024.f) + 1e-6f);
#pragma unroll
        for (int i = 0; i < 4; ++i) { const int col = i * 256 + lane * 4;
            const float4 gg = *(const float4*)(g + col), sc = *(const float4*)(md + scoff + col), sh = *(const float4*)(md + shoff + col);
            u32x2 w; w.x = pk2(v[i].x * rstd * gg.x * (1.f + sc.x) + sh.x, v[i].y * rstd * gg.y * (1.f + sc.y) + sh.y);
            w.y = pk2(v[i].z * rstd * gg.z * (1.f + sc.z) + sh.z, v[i].w * rstd * gg.w * (1.f + sc.w) + sh.w);
            *(u32x2*)(H + (size_t)r * 1024 + col) = w; }
    }
}
__device__ void phase_qkprep(PP p, int l, unsigned char* smem) {
    float2* cs = (float2*)smem;
    const int tid = otid(), lane = tid & 63, gw = blockIdx.x * 8 + (tid >> 6), nw = gridDim.x * 8;
    __syncthreads();
    for (int e = tid; e < 2048; e += 512) { const int pos = e >> 5, fi = e & 31; float sn, c; sincosf((float)pos * powf(10000.f, -(float)fi / 32.f), &sn, &c); cs[e] = make_float2(c, sn); }
    __syncthreads();
    bf16_t* QKV = (bf16_t*)(p->ws + WS_QKV);
    const int j = lane & 15;
    float gq[8], gk[8];
#pragma unroll
    for (int e = 0; e < 8; ++e) { gq[e] = p->q_norm_g[l * 128 + 8 * j + e]; gk[e] = p->k_norm_g[l * 128 + 8 * j + e]; }
    const float sgn = (j & 4) ? 1.f : -1.f;
    for (int r = gw; r < T; r += nw) {
        const int pp = r % RPB; const bool lat = pp >= 256; const int t = pp - 256;
        const int pos = (j < 8) ? (t >> 6) : (t & 63);
        bf16_t* rowp = QKV + (size_t)r * 1536 + lane * 8;
        u32x4 raw[3];
        raw[0] = *(const u32x4*)(rowp); raw[1] = *(const u32x4*)(rowp + 512); raw[2] = (lane < 32) ? *(const u32x4*)(rowp + 1024) : (u32x4){0u, 0u, 0u, 0u};
#pragma unroll
        for (int g = 0; g < 3; ++g) {
            float x[8];
#pragma unroll
            for (int e = 0; e < 4; ++e) { x[2 * e] = __uint_as_float(raw[g][e] << 16); x[2 * e + 1] = __uint_as_float(raw[g][e] & 0xffff0000u); }
            float ss = 0.f;
#pragma unroll
            for (int e = 0; e < 8; ++e) ss += x[e] * x[e];
            ss += __shfl_xor(ss, 1); ss += __shfl_xor(ss, 2); ss += __shfl_xor(ss, 4); ss += __shfl_xor(ss, 8);
            const float rstd = 1.0f / sqrtf(ss * (1.f / 128.f) + 1e-6f);
#pragma unroll
            for (int e = 0; e < 8; ++e) x[e] = x[e] * rstd * (g < 2 ? gq[e] : gk[e]);
            if (lat) {
#pragma unroll
                for (int e = 0; e < 8; ++e) { const float pr = __shfl_xor(x[e], 4); const float2 c2 = cs[pos * 32 + 8 * (j & 3) + e]; x[e] = x[e] * c2.x + sgn * pr * c2.y; }
            }
            u32x4 w; w.x = pk2(x[0], x[1]); w.y = pk2(x[2], x[3]); w.z = pk2(x[4], x[5]); w.w = pk2(x[6], x[7]);
            if (g < 2 || lane < 32) *(u32x4*)(rowp + g * 512) = w;
        }
    }
    __syncthreads();
}
__device__ void phase_readout(PP p, int l, int hh) {
    const int tid = otid(), lane = tid & 63, gw = blockIdx.x * 8 + (tid >> 6), nw = gridDim.x * 8, j = lane & 15;
    const bf16_t* ZH = (const bf16_t*)(p->ws + WS_ZH); const bf16_t* OFB = (const bf16_t*)(p->ws + WS_OFB); bf16_t* HG = (bf16_t*)(p->ws + WS_HG);
    float gn[8];
#pragma unroll
    for (int e = 0; e < 8; ++e) gn[e] = p->hg_norm_g[l * 128 + 8 * j + e];
    for (int r = gw; r < T; r += nw) {
        if (l && (r % RPB) < 256) continue;
        const u32x4 a = *(const u32x4*)(OFB + (size_t)r * 512 + lane * 8), b = *(const u32x4*)(OFB + ((size_t)T + r) * 512 + lane * 8);
        const u32x4 gg = *(const u32x4*)(ZH + (size_t)r * 2560 + 2048 + lane * 8);
        float o[8], g[8];
#pragma unroll
        for (int e = 0; e < 4; ++e) { o[2 * e] = __uint_as_float(a[e] << 16) + __uint_as_float(b[e] << 16); o[2 * e + 1] = __uint_as_float(a[e] & 0xffff0000u) + __uint_as_float(b[e] & 0xffff0000u);
            g[2 * e] = __uint_as_float(gg[e] << 16); g[2 * e + 1] = __uint_as_float(gg[e] & 0xffff0000u); }
        {
          const int pp = r % RPB, bb = r / RPB, hl = lane >> 4; const bf16_t* OC = (const bf16_t*)(p->ws + WS_QS);
          if (pp >= 1152) { const u32x4 cf = *(const u32x4*)(OC + ((size_t)(((bb * 4 + hl) * 2 + 0) * 1152 + (pp - 1152))) * 128 + 8 * j);
#pragma unroll
              for (int e = 0; e < 4; ++e) { o[2 * e] += __uint_as_float(cf[e] << 16); o[2 * e + 1] += __uint_as_float(cf[e] & 0xffff0000u); } }
          if (pp >= 256 && pp <= 1407) { const u32x4 cb = *(const u32x4*)(OC + ((size_t)(((bb * 4 + hl) * 2 + 1) * 1152 + (1407 - pp))) * 128 + 8 * j);
#pragma unroll
              for (int e = 0; e < 4; ++e) { o[2 * e] += __uint_as_float(cb[e] << 16); o[2 * e + 1] += __uint_as_float(cb[e] & 0xffff0000u); } } }
        float ss = 0.f;
#pragma unroll
        for (int e = 0; e < 8; ++e) ss += o[e] * o[e];
        ss += __shfl_xor(ss, 1); ss += __shfl_xor(ss, 2); ss += __shfl_xor(ss, 4); ss += __shfl_xor(ss, 8);
        const float rstd = 1.0f / sqrtf(ss * (1.f / 128.f) + 1e-6f);
#pragma unroll
        for (int e = 0; e < 8; ++e) o[e] = o[e] * rstd * gn[e] * (g[e] * __builtin_amdgcn_rcpf(1.f + __expf(-g[e])));
        u32x4 w; w.x = pk2(o[0], o[1]); w.y = pk2(o[2], o[3]); w.z = pk2(o[4], o[5]); w.w = pk2(o[6], o[7]);
        *(u32x4*)(HG + (size_t)r * 1024 + hh * 512 + lane * 8) = w;
    }
}
__device__ void phase_transpose(PP p, unsigned char* smem) {
    bf16_t* tile = (bf16_t*)smem;
    const bf16_t* HYT = (const bf16_t*)(p->ws + WS_UT); bf16_t* HY = (bf16_t*)(p->ws + WS_HY);
    const int tid = otid();
    for (int g = blockIdx.x; g < (T / 128) * 16; g += gridDim.x) {
        const int t0 = (g >> 4) * 128, c0 = (g & 15) * 64;
        { const int cr = tid >> 3, t8 = (tid & 7) * 8; const bf16_t* src = HYT + (size_t)(c0 + cr) * T + t0 + t8;
          const u32x4 a = *(const u32x4*)(src), b = *(const u32x4*)(src + 64);
          *(u32x4*)(tile + cr * 136 + t8) = a; *(u32x4*)(tile + cr * 136 + t8 + 64) = b; }
        __syncthreads();
        { const int tr = tid >> 2, cq = (tid & 3) * 16; bf16_t v[16];
#pragma unroll
          for (int i = 0; i < 16; ++i) v[i] = tile[(cq + i) * 136 + tr];
          u32x4 w0, w1; w0.x = v[0] | ((unsigned)v[1] << 16); w0.y = v[2] | ((unsigned)v[3] << 16); w0.z = v[4] | ((unsigned)v[5] << 16); w0.w = v[6] | ((unsigned)v[7] << 16);
          w1.x = v[8] | ((unsigned)v[9] << 16); w1.y = v[10] | ((unsigned)v[11] << 16); w1.z = v[12] | ((unsigned)v[13] << 16); w1.w = v[14] | ((unsigned)v[15] << 16);
          bf16_t* dst = HY + (size_t)(t0 + tr) * 1024 + c0 + cq; *(u32x4*)(dst) = w0; *(u32x4*)(dst + 8) = w1; }
        __syncthreads();
    }
}

__device__ void phase_attn(PP p, int l, unsigned char* smem) {
    const att::bf16* QKV = (const att::bf16*)(p->ws + WS_QKV); bf16_t* ATT = (bf16_t*)(p->ws + WS_ATT);
    const int nitems = 512 + (l == 0 ? 64 : 0);
    for (int it = blockIdx.x; it < nitems; it += gridDim.x) {
        int b, h, seq; size_t r0;
        if (it < 512) {
            const int xr = it & 255, rd = it >> 8, pair = rd * 8 + (xr & 7), j = xr >> 3;
            b = pair >> 1; h = (pair & 1) * 4 + (j >> 3); r0 = (size_t)b * RPB + 256 + (size_t)(j & 7) * 256; seq = RPB; }
        else { const int q = it - 512; b = q >> 3; h = q & 7; r0 = (size_t)b * RPB; seq = 256; }
        __syncthreads();
        const att::bf16* Kp = QKV + (size_t)b * RPB * 1536 + 1024 + (h >> 2) * 128;
        att::attn_dense_body<att::bf16>(QKV + r0 * 1536 + h * 128, Kp, Kp + 256, ATT + r0 * 1024 + h * 128, seq, (char*)smem);
    }
    __syncthreads();
}

#define MFMA16(a, b, c) __builtin_amdgcn_mfma_f32_16x16x32_bf16(a, b, c, 0, 0, 0)
#define SCAN_START(cc) (dir == 0 ? 64 * (cc) : ((cc) < 4 ? 255 - 64 * (cc) : 256 + 2047 - 64 * ((cc) - 4)))
__device__ void phase_scan(PP p, int l, int hh, unsigned char* smem) {
    bf16_t* Qhat = (bf16_t*)smem;
    bf16_t* Qtil = Qhat + 64 * 136;
    bf16_t* Khat = Qtil + 64 * 136;
    bf16_t* KtT  = Khat + 160 * 136;
    bf16_t* Vt   = KtT + 128 * 72;
    bf16_t* Pm   = Vt + 64 * 72;
    bf16_t* St   = Pm + 64 * 72;
    float* segsum = (float*)(St + 64 * 136);
    float* dvec = segsum + 1024;
    const bf16_t* ZH = (const bf16_t*)(p->ws + WS_ZH); bf16_t* OFB = (bf16_t*)(p->ws + WS_OFB);
    const int tid = otid(), lane = tid & 63, wid = __builtin_amdgcn_readfirstlane(tid >> 6), li = lane & 15, lg = lane >> 4;
    const int kp = lane, sg8 = wid, Iown = wid >> 1;
    for (int item = blockIdx.x; item < 256; item += gridDim.x) {
        const int sj = item & 1, vh = (item >> 1) & 1, dir = (item >> 2) & 1, hl = (item >> 3) & 3, b = item >> 5, h = hh * 4 + hl, grp = item >> 2;
        float lb[2] = {0.f, 0.f};
        if (l > 0) {
#pragma unroll
            for (int c = 0; c < 2; ++c) { const float r0 = p->hg_lb_raw[(0 * 2 + dir) * 1024 + h * 128 + 2 * kp + c], r1 = p->hg_lb_raw[(1 * 2 + dir) * 1024 + h * 128 + 2 * kp + c];
                const float mx = fmaxf(r0, r1), e0 = expf(r0 - mx), e1 = expf(r1 - mx); const float s0 = e0 / (e0 + e1), s1 = e1 / (e0 + e1); lb[c] = (s0 + s1) - s0; } }
        const float oml[2] = {1.f - lb[0], 1.f - lb[1]};
        __syncthreads();
        for (int e = tid; e < 64 * 136; e += 512) St[e] = 0;
        for (int e = tid; e < 64 * 72; e += 512) Pm[e] = 0;
        f32x4 sacc[4] = {{0.f, 0.f, 0.f, 0.f}, {0.f, 0.f, 0.f, 0.f}, {0.f, 0.f, 0.f, 0.f}, {0.f, 0.f, 0.f, 0.f}};
        unsigned zr[8], qr[8]; u32x4 vr = {0u, 0u, 0u, 0u};
        float runseg[2] = {0.f, 0.f};
        const size_t rb = (size_t)b * RPB;
        const int zcol = (1 + dir) * 512 + hl * 128 + 2 * kp, qcol = hl * 128 + 2 * kp, vcol = 3 * 512 + hl * 128 + vh * 64 + (tid & 7) * 8;
        const int sgn = dir ? -1 : 1, cbeg = 18 * sj;
        bf16_t* QSg = (bf16_t*)(p->ws + WS_QS) + (size_t)grp * 1152 * 128;
#define SCAN_LOAD(cc) do { const int st_ = SCAN_START(cc); \
        _Pragma("unroll") for (int r = 0; r < 8; ++r) { const size_t row_ = rb + (size_t)(st_ + sgn * (sg8 * 8 + r)); zr[r] = *(const unsigned*)(ZH + row_ * 2560 + zcol); qr[r] = *(const unsigned*)(ZH + row_ * 2560 + qcol); } \
        { const size_t row_ = rb + (size_t)(st_ + sgn * (tid >> 3)); vr = *(const u32x4*)(ZH + row_ * 2560 + vcol); } } while (0)
        SCAN_LOAD(cbeg);
        for (int c = cbeg; c < cbeg + 18; ++c) {
            const int start = SCAN_START(c);
            float cum[8][2], kk[8][2], qv[8][2]; float run0 = 0.f, run1 = 0.f;
#pragma unroll
            for (int r = 0; r < 8; ++r) {
#pragma unroll
                for (int cc = 0; cc < 2; ++cc) { const float zz = __uint_as_float(cc ? (zr[r] & 0xffff0000u) : (zr[r] << 16));
                    const float z = fminf(fmaxf(zz, -30.f), 30.f); const float ez = __expf(-z), sg = __builtin_amdgcn_rcpf(1.f + ez), sgm = ez * sg;
                    const float f = lb[cc] + oml[cc] * sg, lf = __builtin_amdgcn_logf(fmaxf(f, 1e-6f));
                    if (cc) { run1 += lf; cum[r][1] = run1; } else { run0 += lf; cum[r][0] = run0; }
                    kk[r][cc] = oml[cc] * sgm; qv[r][cc] = __uint_as_float(cc ? (qr[r] & 0xffff0000u) : (qr[r] << 16)); } }
            *(float2*)(segsum + sg8 * 128 + 2 * kp) = make_float2(run0, run1);
            const u32x4 vcur = vr;
            __syncthreads();
            if (c + 1 < cbeg + 18) SCAN_LOAD(c + 1);
            float pre0[9], pre1[9]; pre0[0] = 0.f; pre1[0] = 0.f;
#pragma unroll
            for (int j = 0; j < 8; ++j) { const float2 sj2 = *(const float2*)(segsum + j * 128 + 2 * kp); pre0[j + 1] = pre0[j] + sj2.x; pre1[j + 1] = pre1[j] + sj2.y; }
            float myc0[2], mys[2], lastv[2], e1[2], e2[2], e3[2], eseg[2], eqs[2];
            myc0[0] = Iown == 0 ? 0.f : (Iown == 1 ? pre0[2] : (Iown == 2 ? pre0[4] : pre0[6])); myc0[1] = Iown == 0 ? 0.f : (Iown == 1 ? pre1[2] : (Iown == 2 ? pre1[4] : pre1[6]));
            { float a0 = pre0[0], a1 = pre1[0];
#pragma unroll
              for (int j = 1; j < 8; ++j) { if (sg8 == j) { a0 = pre0[j]; a1 = pre1[j]; } }
              mys[0] = a0; mys[1] = a1; }
            lastv[0] = pre0[8]; lastv[1] = pre1[8];
            e1[0] = __builtin_amdgcn_exp2f(pre0[2] - myc0[0]); e1[1] = __builtin_amdgcn_exp2f(pre1[2] - myc0[1]); e2[0] = __builtin_amdgcn_exp2f(pre0[4] - myc0[0]); e2[1] = __builtin_amdgcn_exp2f(pre1[4] - myc0[1]);
            e3[0] = __builtin_amdgcn_exp2f(pre0[6] - myc0[0]); e3[1] = __builtin_amdgcn_exp2f(pre1[6] - myc0[1]); eseg[0] = __builtin_amdgcn_exp2f(myc0[0]); eseg[1] = __builtin_amdgcn_exp2f(myc0[1]);
            eqs[0] = eseg[0] * __builtin_amdgcn_exp2f(runseg[0]); eqs[1] = eseg[1] * __builtin_amdgcn_exp2f(runseg[1]);
            const float elast[2] = {__builtin_amdgcn_exp2f(lastv[0] - myc0[0]), __builtin_amdgcn_exp2f(lastv[1] - myc0[1])};
            const bool wqs = (sj == 1) && (vh == 0);
            unsigned ktp[2][4];
#pragma unroll
            for (int r = 0; r < 8; ++r) { const int t = sg8 * 8 + r;
                float qh[2], kb[2], kt[2];
#pragma unroll
                for (int cc = 0; cc < 2; ++cc) { const float ca = mys[cc] + cum[r][cc], clb = ca - myc0[cc];
                    qh[cc] = qv[r][cc] * __builtin_amdgcn_exp2f(clb); kb[cc] = kk[r][cc] * __builtin_amdgcn_exp2f(fminf(-clb, 86.f)); kt[cc] = kb[cc] * elast[cc]; }
                *(unsigned*)(Qhat + t * 136 + 2 * kp) = pk2(qh[0], qh[1]);
                *(unsigned*)(Qtil + t * 136 + 2 * kp) = pk2(qh[0] * eseg[0], qh[1] * eseg[1]);
                if (wqs) *(unsigned*)(QSg + ((size_t)(c - 18) * 64 + t) * 128 + 2 * kp) = pk2(qh[0] * eqs[0], qh[1] * eqs[1]);
                if (Iown == 0) *(unsigned*)(Khat + (0 + t) * 136 + 2 * kp)  = pk2(kb[0], kb[1]);
                if (Iown <= 1) *(unsigned*)(Khat + (16 + t) * 136 + 2 * kp) = (Iown == 1) ? pk2(kb[0], kb[1]) : pk2(kb[0] * e1[0], kb[1] * e1[1]);
                if (Iown <= 2) *(unsigned*)(Khat + (48 + t) * 136 + 2 * kp) = (Iown == 2) ? pk2(kb[0], kb[1]) : pk2(kb[0] * e2[0], kb[1] * e2[1]);
                *(unsigned*)(Khat + (96 + t) * 136 + 2 * kp) = (Iown == 3) ? pk2(kb[0], kb[1]) : pk2(kb[0] * e3[0], kb[1] * e3[1]);
                const unsigned k0b = f2bf(kt[0]), k1b = f2bf(kt[1]);
                if (r & 1) { ktp[0][r >> 1] |= k0b << 16; ktp[1][r >> 1] |= k1b << 16; } else { ktp[0][r >> 1] = k0b; ktp[1][r >> 1] = k1b; } }
            runseg[0] += lastv[0]; runseg[1] += lastv[1];
#pragma unroll
            for (int cc = 0; cc < 2; ++cc) { u32x4 w0 = {ktp[cc][0], ktp[cc][1], ktp[cc][2], ktp[cc][3]}; *(u32x4*)(KtT + (2 * kp + cc) * 72 + sg8 * 8) = w0; }
            if (sg8 == 0) *(float2*)(dvec + 2 * kp) = make_float2(__builtin_amdgcn_exp2f(lastv[0]), __builtin_amdgcn_exp2f(lastv[1]));
            { const int s = tid >> 3, v8 = (tid & 7) * 8;
#pragma unroll
              for (int j = 0; j < 4; ++j) { Vt[(v8 + 2 * j) * 72 + s] = (bf16_t)(vcur[j] & 0xffffu); Vt[(v8 + 2 * j + 1) * 72 + s] = (bf16_t)(vcur[j] >> 16); } }
            __syncthreads();
            for (int idx = wid; idx < 10; idx += 8) {
                const int I = idx >= 6 ? 3 : (idx >= 3 ? 2 : (idx >= 1 ? 1 : 0)), J = idx - I * (I + 1) / 2, koff = I == 0 ? 0 : (I == 1 ? 16 : (I == 2 ? 48 : 96));
                f32x4 acc = {0.f, 0.f, 0.f, 0.f};
#pragma unroll
                for (int ks = 0; ks < 4; ++ks) { const bf16x8 a = *(const bf16x8*)(Qhat + (16 * I + li) * 136 + ks * 32 + lg * 8);
                    const bf16x8 bb = *(const bf16x8*)(Khat + (koff + 16 * J + li) * 136 + ks * 32 + lg * 8); acc = MFMA16(a, bb, acc); }
#pragma unroll
                for (int r = 0; r < 4; ++r) { const int tl = 4 * lg + r; float v = acc[r]; if (I == J && li > tl) v = 0.f; Pm[(16 * I + tl) * 72 + 16 * J + li] = f2bf_sw(v); }
            }
            __syncthreads();
            { const int tI = wid >> 1;
              bf16x8 aq[4], ap[2];
#pragma unroll
              for (int ks = 0; ks < 4; ++ks) aq[ks] = *(const bf16x8*)(Qtil + (16 * tI + li) * 136 + ks * 32 + lg * 8);
#pragma unroll
              for (int ks = 0; ks < 2; ++ks) ap[ks] = *(const bf16x8*)(Pm + (16 * tI + li) * 72 + ks * 32 + lg * 8);
#pragma unroll
              for (int jv = 0; jv < 2; ++jv) { const int vJ = 2 * (wid & 1) + jv; f32x4 acc = {0.f, 0.f, 0.f, 0.f};
#pragma unroll
                  for (int ks = 0; ks < 4; ++ks) { const bf16x8 bb = *(const bf16x8*)(St + (16 * vJ + li) * 136 + ks * 32 + lg * 8); acc = MFMA16(aq[ks], bb, acc); }
#pragma unroll
                  for (int ks = 0; ks < 2; ++ks) { const bf16x8 bb = *(const bf16x8*)(Vt + (16 * vJ + li) * 72 + ks * 32 + lg * 8); acc = MFMA16(ap[ks], bb, acc); }
#pragma unroll
                  for (int r = 0; r < 4; ++r) { const int t = 16 * tI + 4 * lg + r; const size_t row = rb + (size_t)(start + sgn * t);
                      OFB[((size_t)dir * T + row) * 512 + hl * 128 + vh * 64 + 16 * vJ + li] = f2bf_sw(acc[r]); } } }
            { const int vI = wid & 3;
              bf16x8 av[2];
#pragma unroll
              for (int ks = 0; ks < 2; ++ks) av[ks] = *(const bf16x8*)(Vt + (16 * vI + li) * 72 + ks * 32 + lg * 8);
#pragma unroll
              for (int jj = 0; jj < 4; ++jj) { const int kJ = (wid >> 2) * 4 + jj; const float dk = dvec[16 * kJ + li];
                  sacc[jj] = sacc[jj] * dk;
#pragma unroll
                  for (int ks = 0; ks < 2; ++ks) { const bf16x8 bb = *(const bf16x8*)(KtT + (16 * kJ + li) * 72 + ks * 32 + lg * 8); sacc[jj] = MFMA16(av[ks], bb, sacc[jj]); } } }
            __syncthreads();
            { const int vI = wid & 3;
#pragma unroll
              for (int jj = 0; jj < 4; ++jj) { const int kJ = (wid >> 2) * 4 + jj;
#pragma unroll
                  for (int r = 0; r < 4; ++r) St[(16 * vI + 4 * lg + r) * 136 + 16 * kJ + li] = f2bf_sw(sacc[jj][r]); } }
        }
        if (sj == 0) {
            float* S0 = (float*)(p->ws + WS_ST0) + ((size_t)grp * 2 + vh) * 64 * 128; const int vI = wid & 3;
#pragma unroll
            for (int jj = 0; jj < 4; ++jj) { const int kJ = (wid >> 2) * 4 + jj;
#pragma unroll
                for (int r = 0; r < 4; ++r) S0[(16 * vI + 4 * lg + r) * 128 + 16 * kJ + li] = sacc[jj][r]; }
        }
#undef SCAN_LOAD
    }
    __syncthreads();
}
__device__ void phase_scan_corr(PP p, unsigned char* smem) {
    bf16_t* Qs = (bf16_t*)smem;
    bf16_t* St = Qs + 64 * 136;
    const int tid = otid(), lane = tid & 63, wid = __builtin_amdgcn_readfirstlane(tid >> 6), li = lane & 15, lg = lane >> 4;
    for (int item = blockIdx.x; item < 256; item += gridDim.x) {
        const int part = item & 3, grp = item >> 2;
        const float* S0 = (const float*)(p->ws + WS_ST0) + (size_t)grp * 2 * 64 * 128;
        bf16_t* QSg = (bf16_t*)(p->ws + WS_QS) + (size_t)grp * 1152 * 128;
        __syncthreads();
#pragma unroll
        for (int j = 0; j < 2; ++j) { const int e = tid + 512 * j, v = e >> 3, k16 = (e & 7) * 16; const float4* sp = (const float4*)(S0 + v * 128 + k16);
          const float4 a = sp[0], b4 = sp[1], c4 = sp[2], d4 = sp[3];
          u32x4 w0 = {pk2(a.x, a.y), pk2(a.z, a.w), pk2(b4.x, b4.y), pk2(b4.z, b4.w)}, w1 = {pk2(c4.x, c4.y), pk2(c4.z, c4.w), pk2(d4.x, d4.y), pk2(d4.z, d4.w)};
          *(u32x4*)(St + v * 136 + k16) = w0; *(u32x4*)(St + v * 136 + k16 + 8) = w1; }
        for (int cl = (18 * part) >> 2; cl < (18 * (part + 1)) >> 2; ++cl) {
            __syncthreads();
#pragma unroll
            for (int j = 0; j < 2; ++j) { const int e = tid + 512 * j, row = e >> 4, c8 = (e & 15) * 8;
                *(u32x4*)(Qs + row * 136 + c8) = *(const u32x4*)(QSg + ((size_t)cl * 64 + row) * 128 + c8); }
            __syncthreads();
            const int tI = wid >> 1;
#pragma unroll
            for (int jv = 0; jv < 4; ++jv) { const int vJ = 4 * (wid & 1) + jv; f32x4 acc = {0.f, 0.f, 0.f, 0.f};
#pragma unroll
                for (int ks = 0; ks < 4; ++ks) { const bf16x8 a = *(const bf16x8*)(Qs + (16 * tI + li) * 136 + ks * 32 + lg * 8);
                    const bf16x8 bb = *(const bf16x8*)(St + (16 * vJ + li) * 136 + ks * 32 + lg * 8); acc = MFMA16(a, bb, acc); }
#pragma unroll
                for (int r = 0; r < 4; ++r) QSg[((size_t)cl * 64 + 16 * tI + 4 * lg + r) * 128 + 16 * vJ + li] = f2bf_sw(acc[r]); }
        }
    }
    __syncthreads();
}
#undef SCAN_START

__device__ __forceinline__ float2 cmul(float2 a, float2 b) { return make_float2(a.x * b.x - a.y * b.y, a.x * b.y + a.y * b.x); }
template <int M, bool INV>
__device__ __forceinline__ void fft_r4(float2*& x, float2*& y, const float2* tw, int nseq, int tid) {
    constexpr int NP = (M == 4096) ? 6 : 5, Q = M / 4, TS = 4096 / M;
#pragma unroll 1
    for (int ps = 0; ps < NP; ++ps) {
        const int sh = 2 * ps, s = 1 << sh, n1 = Q >> sh;
        for (int idx = tid; idx < nseq * Q; idx += 512) {
            const int sq = idx / Q, j = idx % Q, pq = j >> sh, q = j & (s - 1);
            float2 w1 = tw[(pq << sh) * TS]; if (INV) w1.y = -w1.y;
            const float2 w2 = cmul(w1, w1), w3 = cmul(w2, w1);
            const float2* xs = x + sq * M + q + s * pq; float2* ys = y + sq * M + q + s * 4 * pq;
            const float2 a = xs[0], b = xs[s * n1], c = xs[2 * s * n1], d = xs[3 * s * n1];
            const float2 apc = make_float2(a.x + c.x, a.y + c.y), amc = make_float2(a.x - c.x, a.y - c.y);
            const float2 bpd = make_float2(b.x + d.x, b.y + d.y), bmd = make_float2(b.x - d.x, b.y - d.y);
            const float2 jb = INV ? make_float2(bmd.y, -bmd.x) : make_float2(-bmd.y, bmd.x);
            ys[0] = make_float2(apc.x + bpd.x, apc.y + bpd.y);
            ys[s] = cmul(w1, make_float2(amc.x - jb.x, amc.y - jb.y));
            ys[2 * s] = cmul(w2, make_float2(apc.x - bpd.x, apc.y - bpd.y));
            ys[3 * s] = cmul(w3, make_float2(amc.x + jb.x, amc.y + jb.y));
        }
        __syncthreads();
        float2* t = x; x = y; y = t;
    }
}
constexpr float HY_MIN_DECAY_C = -3.0701134573253945f, HY_MAX_DECAY_C = -15.350567286626972f;

template <int N, int M>
__device__ __forceinline__ void hyena_filter(PP p, int l, int c, const float* hid, float2*& x, float2*& y, float2* Hs0, float2* Hs1, const float2* tw, float* w3s, float* red) {
    const int tid = otid(), lane = tid & 63, wid = tid >> 6;
    if (tid < 256) { const int q = tid >> 6, j = tid & 63; w3s[tid] = p->hy_filt_w3[((size_t)l * 64 + j) * 4096 + (q >> 1) * 2048 + (q & 1) * 1024 + c]; }
    for (int e = tid; e < M; e += 512) x[e] = make_float2(0.f, 0.f);
    __syncthreads();
    const float delta = fabsf(HY_MIN_DECAY_C + (float)c * ((HY_MAX_DECAY_C - HY_MIN_DECAY_C) / 1023.f));
    constexpr int NL = (N + 511) / 512;
    float as0 = 0.f, as1 = 0.f;
#pragma unroll 1
    for (int jl = 0; jl < NL; ++jl) { const int i = tid + 512 * jl;
        if (i < N) { const float ti = (float)i / (float)(N - 1), dec = __expf(-ti * delta); const float4* hr = (const float4*)(hid + (size_t)i * 64);
            float4 hv[16];
#pragma unroll
            for (int j = 0; j < 16; ++j) hv[j] = hr[j];
            float d0 = 0.f, d1 = 0.f, d2 = 0.f, d3 = 0.f;
#pragma unroll
            for (int j = 0; j < 16; ++j) {
                d0 += hv[j].x * w3s[4 * j] + hv[j].y * w3s[4 * j + 1] + hv[j].z * w3s[4 * j + 2] + hv[j].w * w3s[4 * j + 3];
                d1 += hv[j].x * w3s[64 + 4 * j] + hv[j].y * w3s[64 + 4 * j + 1] + hv[j].z * w3s[64 + 4 * j + 2] + hv[j].w * w3s[64 + 4 * j + 3];
                d2 += hv[j].x * w3s[128 + 4 * j] + hv[j].y * w3s[128 + 4 * j + 1] + hv[j].z * w3s[128 + 4 * j + 2] + hv[j].w * w3s[128 + 4 * j + 3];
                d3 += hv[j].x * w3s[192 + 4 * j] + hv[j].y * w3s[192 + 4 * j + 1] + hv[j].z * w3s[192 + 4 * j + 2] + hv[j].w * w3s[192 + 4 * j + 3]; }
            d0 *= dec; d1 *= dec; d2 *= dec; d3 *= dec;
            x[i] = make_float2(d0, d2); if (i >= 1) x[M - i] = make_float2(d1, d3);
            as0 += fabsf(d0) + (i >= 1 ? fabsf(d1) : 0.f); as1 += fabsf(d2) + (i >= 1 ? fabsf(d3) : 0.f); } }
    as0 = wave_sum(as0); as1 = wave_sum(as1);
    if (lane == 0) { red[wid * 2] = as0; red[wid * 2 + 1] = as1; }
    __syncthreads();
    float t0 = 0.f, t1 = 0.f;
#pragma unroll
    for (int w = 0; w < 8; ++w) { t0 += red[w * 2]; t1 += red[w * 2 + 1]; }
    const float sc0 = 1.f / (t0 + 1e-6f), sc1 = 1.f / (t1 + 1e-6f);
    for (int e = tid; e < M; e += 512) { const float2 v = x[e]; x[e] = make_float2(v.x * sc0, v.y * sc1); }
    __syncthreads();
    fft_r4<M, false>(x, y, tw, 1, tid);
    constexpr float HSC = 0.5f / (float)M;
    for (int kx = tid; kx < M; kx += 512) { const float2 zk = x[kx], zm = x[(M - kx) & (M - 1)];
        Hs0[kx] = make_float2(HSC * (zk.x + zm.x), HSC * (zk.y - zm.y));
        Hs1[kx] = make_float2(HSC * (zk.y + zm.y), -HSC * (zk.x - zm.x)); }
    __syncthreads();
}
template <int N, int M, int NSEQ>
__device__ __forceinline__ void hyena_seqs(PP p, int l, int c, int pair0, int tokoff, float2*& x, float2*& y, const float2* Hs0, const float2* Hs1, const float2* tw, bf16_t* UT) {
    const int tid = otid();
    constexpr int NE = N * NSEQ / 512;
    float sw[3][3], sb[3];
#pragma unroll
    for (int sec = 0; sec < 3; ++sec) { sb[sec] = p->hy_short_b[l * 3072 + sec * 1024 + c];
#pragma unroll
        for (int tap = 0; tap < 3; ++tap) sw[sec][tap] = p->hy_short_w[((size_t)l * 3 + tap) * 3072 + sec * 1024 + c]; }
    const float bias0 = p->hy_bias[(l * 2 + 0) * 1024 + c], bias1 = p->hy_bias[(l * 2 + 1) * 1024 + c];
#define HY_SCONV(sec, pr, t, out) do { const bf16_t* u0_ = UT + (size_t)((sec) * 1024 + c) * T + (size_t)(2 * (pr)) * RPB + tokoff; const bf16_t* u1_ = u0_ + RPB; \
        const float a0_ = (t) > 0 ? bf2f(u0_[(t) - 1]) : 0.f, a1_ = bf2f(u0_[(t)]), a2_ = (t) < N - 1 ? bf2f(u0_[(t) + 1]) : 0.f; \
        const float b0_ = (t) > 0 ? bf2f(u1_[(t) - 1]) : 0.f, b1_ = bf2f(u1_[(t)]), b2_ = (t) < N - 1 ? bf2f(u1_[(t) + 1]) : 0.f; \
        out = make_float2(a0_ * sw[sec][0] + a1_ * sw[sec][1] + a2_ * sw[sec][2] + sb[sec], b0_ * sw[sec][0] + b1_ * sw[sec][1] + b2_ * sw[sec][2] + sb[sec]); } while (0)
    float2 vz[NE], z1[NE];
#pragma unroll
    for (int j = 0; j < NE; ++j) { const int e = tid + 512 * j, pl = e / N, t = e % N; HY_SCONV(2, pair0 + pl, t, vz[j]); x[pl * M + t] = vz[j]; }
    for (int e = tid; e < NSEQ * (M - N); e += 512) { const int pl = e / (M - N), t = N + e % (M - N); x[pl * M + t] = make_float2(0.f, 0.f); }
    __syncthreads();
    fft_r4<M, false>(x, y, tw, NSEQ, tid);
    for (int e = tid; e < NSEQ * M; e += 512) x[e] = cmul(x[e], Hs0[e & (M - 1)]);
    __syncthreads();
    fft_r4<M, true>(x, y, tw, NSEQ, tid);
#pragma unroll
    for (int j = 0; j < NE; ++j) { const int e = tid + 512 * j, pl = e / N, t = e % N; const float2 zc = x[pl * M + t]; float2 x1; HY_SCONV(0, pair0 + pl, t, x1);
        z1[j] = make_float2(x1.x * (zc.x + vz[j].x * bias0), x1.y * (zc.y + vz[j].y * bias0)); }
    __syncthreads();
#pragma unroll
    for (int j = 0; j < NE; ++j) { const int e = tid + 512 * j, pl = e / N, t = e % N; x[pl * M + t] = z1[j]; }
    for (int e = tid; e < NSEQ * (M - N); e += 512) { const int pl = e / (M - N), t = N + e % (M - N); x[pl * M + t] = make_float2(0.f, 0.f); }
    __syncthreads();
    fft_r4<M, false>(x, y, tw, NSEQ, tid);
    for (int e = tid; e < NSEQ * M; e += 512) x[e] = cmul(x[e], Hs1[e & (M - 1)]);
    __syncthreads();
    fft_r4<M, true>(x, y, tw, NSEQ, tid);
#pragma unroll
    for (int j = 0; j < NE; ++j) { const int e = tid + 512 * j, pl = e / N, t = e % N; const float2 zc = x[pl * M + t]; float2 x2; HY_SCONV(1, pair0 + pl, t, x2);
        bf16_t* o0 = UT + (size_t)c * T + (size_t)(2 * (pair0 + pl)) * RPB + tokoff + t;
        o0[0] = f2bf(x2.x * (zc.x + z1[j].x * bias1)); o0[RPB] = f2bf(x2.y * (zc.y + z1[j].y * bias1)); }
    __syncthreads();
#undef HY_SCONV
}
template <bool INV>
__device__ __forceinline__ void r4bf(float2& a, float2& b, float2& c, float2& d, float2 w1, float2 w2, float2 w3) {
    const float2 apc = make_float2(a.x + c.x, a.y + c.y), amc = make_float2(a.x - c.x, a.y - c.y);
    const float2 bpd = make_float2(b.x + d.x, b.y + d.y), bmd = make_float2(b.x - d.x, b.y - d.y);
    const float2 jb = INV ? make_float2(bmd.y, -bmd.x) : make_float2(-bmd.y, bmd.x);
    a = make_float2(apc.x + bpd.x, apc.y + bpd.y);
    b = cmul(w1, make_float2(amc.x - jb.x, amc.y - jb.y));
    c = cmul(w2, make_float2(apc.x - bpd.x, apc.y - bpd.y));
    d = cmul(w3, make_float2(amc.x + jb.x, amc.y + jb.y));
}
template <bool INV, bool WONE = false>
__device__ __forceinline__ void r16bf(float2 (&v)[16], float2 W) {
    constexpr float C16[10] = {1.f, 0.92387953251128674f, 0.70710678118654752f, 0.38268343236508977f, 0.f, -0.38268343236508977f, -0.70710678118654752f, -0.92387953251128674f, -1.f, -0.92387953251128674f};
    constexpr float S16[10] = {0.f, 0.38268343236508977f, 0.70710678118654752f, 0.92387953251128674f, 1.f, 0.92387953251128674f, 0.70710678118654752f, 0.38268343236508977f, 0.f, -0.38268343236508977f};
    if (WONE) W = make_float2(1.f, 0.f);
    if (INV) W.y = -W.y;
    const float2 W2 = cmul(W, W), W3 = cmul(W2, W), W4 = cmul(W2, W2), W8 = cmul(W4, W4), W12 = cmul(W8, W4);
#pragma unroll
    for (int mp = 0; mp < 4; ++mp) {
        const float2 o1 = make_float2(C16[mp], INV ? S16[mp] : -S16[mp]), o2 = make_float2(C16[2 * mp], INV ? S16[2 * mp] : -S16[2 * mp]), o3 = make_float2(C16[3 * mp], INV ? S16[3 * mp] : -S16[3 * mp]);
        r4bf<INV>(v[mp], v[mp + 4], v[mp + 8], v[mp + 12], cmul(W, o1), cmul(W2, o2), cmul(W3, o3));
    }
    float2 t[16];
#pragma unroll
    for (int m = 0; m < 4; ++m) { float2 a = v[4 * m], b = v[4 * m + 1], c = v[4 * m + 2], d = v[4 * m + 3]; r4bf<INV>(a, b, c, d, W4, W8, W12); t[m] = a; t[m + 4] = b; t[m + 8] = c; t[m + 12] = d; }
#pragma unroll
    for (int o = 0; o < 16; ++o) v[o] = t[o];
}
constexpr int HSEQ = 4352;
template <bool INV>
__device__ __forceinline__ void fft4096_tail(float2 (&v)[16], float2* xb, const float2* tw, int u, bool active) {
    if (active) {
#pragma unroll
        for (int o = 0; o < 16; ++o) xb[17 * u + o] = v[o]; }
    __syncthreads();
    if (active) {
#pragma unroll
        for (int r = 0; r < 16; ++r) v[r] = xb[u + 256 * r + (u >> 4) + 16 * r]; }
    __syncthreads();
    if (active) { r16bf<INV>(v, tw[u & ~15]);
        const int q = u & 15, pp = u >> 4;
#pragma unroll
        for (int o = 0; o < 16; ++o) xb[q + 256 * pp + 16 * o] = v[o]; }
    __syncthreads();
    if (active) {
#pragma unroll
        for (int r = 0; r < 16; ++r) v[r] = xb[u + 256 * r]; }
    __syncthreads();
    if (active) r16bf<INV>(v, tw[0]);
}
__device__ __forceinline__ void hyena_lat2(PP p, int l, int c, int pair0, float2* buf, const float2* Hs0, const float2* Hs1, const float2* tw, bf16_t* UT) {
    const int tid = otid(), sq = tid >> 8, u = tid & 255, pair = pair0 + sq;
    float2* xb = buf + sq * HSEQ;
    float sw[3][3], sb[3];
#pragma unroll
    for (int sec = 0; sec < 3; ++sec) { sb[sec] = p->hy_short_b[l * 3072 + sec * 1024 + c];
#pragma unroll
        for (int tap = 0; tap < 3; ++tap) sw[sec][tap] = p->hy_short_w[((size_t)l * 3 + tap) * 3072 + sec * 1024 + c]; }
    const float bias0 = p->hy_bias[(l * 2 + 0) * 1024 + c], bias1 = p->hy_bias[(l * 2 + 1) * 1024 + c];
#define HY_SCONV2(sec, t, out) do { const bf16_t* u0_ = UT + (size_t)((sec) * 1024 + c) * T + (size_t)(2 * pair) * RPB + 256; const bf16_t* u1_ = u0_ + RPB; \
        const float a0_ = (t) > 0 ? bf2f(u0_[(t) - 1]) : 0.f, a1_ = bf2f(u0_[(t)]), a2_ = (t) < 2047 ? bf2f(u0_[(t) + 1]) : 0.f; \
        const float b0_ = (t) > 0 ? bf2f(u1_[(t) - 1]) : 0.f, b1_ = bf2f(u1_[(t)]), b2_ = (t) < 2047 ? bf2f(u1_[(t) + 1]) : 0.f; \
        out = make_float2(a0_ * sw[sec][0] + a1_ * sw[sec][1] + a2_ * sw[sec][2] + sb[sec], b0_ * sw[sec][0] + b1_ * sw[sec][1] + b2_ * sw[sec][2] + sb[sec]); } while (0)
    float2 v[16], vz[8], z1[8], x1c[8], x2c[8];
#pragma unroll
    for (int r = 0; r < 8; ++r) { HY_SCONV2(2, u + 256 * r, vz[r]); v[r] = vz[r]; v[8 + r] = make_float2(0.f, 0.f); }
#pragma unroll
    for (int r = 0; r < 8; ++r) { HY_SCONV2(0, u + 256 * r, x1c[r]); }
#pragma unroll
    for (int r = 0; r < 8; ++r) { HY_SCONV2(1, u + 256 * r, x2c[r]); }
    r16bf<false>(v, tw[u]); fft4096_tail<false>(v, xb, tw, u, true);
#pragma unroll
    for (int o = 0; o < 16; ++o) v[o] = cmul(v[o], Hs0[u + 256 * o]);
    r16bf<true>(v, tw[u]); fft4096_tail<true>(v, xb, tw, u, true);
#pragma unroll
    for (int r = 0; r < 8; ++r) { const float2 x1 = x1c[r]; z1[r] = make_float2(x1.x * (v[r].x + vz[r].x * bias0), x1.y * (v[r].y + vz[r].y * bias0)); v[r] = z1[r]; }
#pragma unroll
    for (int r = 8; r < 16; ++r) v[r] = make_float2(0.f, 0.f);
    __syncthreads();
    r16bf<false>(v, tw[u]); fft4096_tail<false>(v, xb, tw, u, true);
#pragma unroll
    for (int o = 0; o < 16; ++o) v[o] = cmul(v[o], Hs1[u + 256 * o]);
    r16bf<true>(v, tw[u]); fft4096_tail<true>(v, xb, tw, u, true);
#pragma unroll
    for (int r = 0; r < 8; ++r) { const float2 x2 = x2c[r];
        bf16_t* o0 = UT + (size_t)c * T + (size_t)(2 * pair) * RPB + 256 + u + 256 * r;
        o0[0] = f2bf(x2.x * (v[r].x + z1[r].x * bias1)); o0[RPB] = f2bf(x2.y * (v[r].y + z1[r].y * bias1)); }
    __syncthreads();
#undef HY_SCONV2
}
__device__ __forceinline__ void hyena_filter_lat(PP p, int l, int c, const float* hid, float2* buf, float2* Hs0, float2* Hs1, const float2* tw, float* w3s, float* red) {
    constexpr int N = 2048, M = 4096;
    const int tid = otid(), lane = tid & 63, wid = tid >> 6;
    float2* x = buf;
    if (tid < 256) { const int q = tid >> 6, j = tid & 63; w3s[tid] = p->hy_filt_w3[((size_t)l * 64 + j) * 4096 + (q >> 1) * 2048 + (q & 1) * 1024 + c]; }
    for (int e = tid; e < M; e += 512) x[e] = make_float2(0.f, 0.f);
    __syncthreads();
    const float delta = fabsf(HY_MIN_DECAY_C + (float)c * ((HY_MAX_DECAY_C - HY_MIN_DECAY_C) / 1023.f));
    float as0 = 0.f, as1 = 0.f;
#pragma unroll 1
    for (int jl = 0; jl < 4; ++jl) { const int i = tid + 512 * jl;
        const float ti = (float)i / (float)(N - 1), dec = __expf(-ti * delta); const float4* hr = (const float4*)(hid + (size_t)i * 64);
        float4 hv[16];
#pragma unroll
        for (int j = 0; j < 16; ++j) hv[j] = hr[j];
        float d0 = 0.f, d1 = 0.f, d2 = 0.f, d3 = 0.f;
#pragma unroll
        for (int j = 0; j < 16; ++j) {
            d0 += hv[j].x * w3s[4 * j] + hv[j].y * w3s[4 * j + 1] + hv[j].z * w3s[4 * j + 2] + hv[j].w * w3s[4 * j + 3];
            d1 += hv[j].x * w3s[64 + 4 * j] + hv[j].y * w3s[64 + 4 * j + 1] + hv[j].z * w3s[64 + 4 * j + 2] + hv[j].w * w3s[64 + 4 * j + 3];
            d2 += hv[j].x * w3s[128 + 4 * j] + hv[j].y * w3s[128 + 4 * j + 1] + hv[j].z * w3s[128 + 4 * j + 2] + hv[j].w * w3s[128 + 4 * j + 3];
            d3 += hv[j].x * w3s[192 + 4 * j] + hv[j].y * w3s[192 + 4 * j + 1] + hv[j].z * w3s[192 + 4 * j + 2] + hv[j].w * w3s[192 + 4 * j + 3]; }
        d0 *= dec; d1 *= dec; d2 *= dec; d3 *= dec;
        x[i] = make_float2(d0, d2); if (i >= 1) x[M - i] = make_float2(d1, d3);
        as0 += fabsf(d0) + (i >= 1 ? fabsf(d1) : 0.f); as1 += fabsf(d2) + (i >= 1 ? fabsf(d3) : 0.f); }
    as0 = wave_sum(as0); as1 = wave_sum(as1);
    if (lane == 0) { red[wid * 2] = as0; red[wid * 2 + 1] = as1; }
    __syncthreads();
    float t0 = 0.f, t1 = 0.f;
#pragma unroll
    for (int w = 0; w < 8; ++w) { t0 += red[w * 2]; t1 += red[w * 2 + 1]; }
    const float sc0 = 1.f / (t0 + 1e-6f), sc1 = 1.f / (t1 + 1e-6f);
    const bool active = tid < 256; const int u = tid & 255;
    float2 v[16];
    if (active) {
#pragma unroll
        for (int r = 0; r < 16; ++r) { const float2 a = x[u + 256 * r]; v[r] = make_float2(a.x * sc0, a.y * sc1); } }
    __syncthreads();
    if (active) r16bf<false>(v, tw[u]);
    fft4096_tail<false>(v, x, tw, u, active);
    constexpr float HSC = 0.5f / (float)M;
    if (active) {
#pragma unroll
        for (int o = 0; o < 16; ++o) x[u + 256 * o] = v[o]; }
    __syncthreads();
    for (int kx = tid; kx < M; kx += 512) { const float2 zk = x[kx], zm = x[(M - kx) & (M - 1)];
        Hs0[kx] = make_float2(HSC * (zk.x + zm.x), HSC * (zk.y - zm.y));
        Hs1[kx] = make_float2(HSC * (zk.y + zm.y), -HSC * (zk.x - zm.x)); }
    __syncthreads();
}
__device__ void phase_hyena(PP p, int l, unsigned char* smem) {
    float2* buf = (float2*)smem; float2* Hs0 = buf + 2 * HSEQ; float2* Hs1 = Hs0 + 4096; float2* tw = Hs1 + 4096;
    float* w3s = (float*)(tw + 1024); float* red = w3s + 256;
    const int tid = otid();
    bf16_t* UT = (bf16_t*)(p->ws + WS_UT);
    const float* HID = (const float*)(p->ws + WS_HIDF) + (size_t)l * 2304 * 64;
    __syncthreads();
    for (int e = tid; e < 1024; e += 512) { float s, c; sincospif((float)e / 2048.f, &s, &c); tw[e] = make_float2(c, -s); }
    __syncthreads();
    for (int c = blockIdx.x; c < 1024; c += gridDim.x) {
        hyena_filter_lat(p, l, c, HID, buf, Hs0, Hs1, tw, w3s, red);
        hyena_lat2(p, l, c, 0, buf, Hs0, Hs1, tw, UT);
        hyena_lat2(p, l, c, 2, buf, Hs0, Hs1, tw, UT);
        if (l == 0) {
            float2* x = buf; float2* y = buf + 4096;
            hyena_filter<256, 1024>(p, l, c, HID + (size_t)2048 * 64, x, y, Hs0, Hs1, tw, w3s, red);
            hyena_seqs<256, 1024, 4>(p, l, c, 0, 0, x, y, Hs0, Hs1, tw, UT);
        }
    }
    __syncthreads();
}

constexpr int PH_PER_LAYER = 20, N_PHASES = 1 + 2 * PH_PER_LAYER;
__device__ __forceinline__ void run_phase(PP p, int ph, unsigned char* smem) {
#ifndef NO_PH0
    if (ph == 0) { conv_weights(p, 0, smem, 0, 6272, 0); prep_hid(p); prep_mods(p, smem);
        return; }
#endif
    const int l = (ph - 1) / PH_PER_LAYER, ik = (ph - 1) % PH_PER_LAYER;
    const int k = ik < 6 ? ik : (ik == 6 ? 18 : (ik < 10 ? ik - 1 : (ik == 10 ? 19 : ik - 2)));
#ifndef PH_MASK
#define PH_MASK 0xfffff
#endif
#define ON(kk) (((PH_MASK) >> (kk)) & 1)
    const float* xl_in = p->out; const float* xc_in = (const float*)(p->ws + WS_XC);
    float* XC = (float*)(p->ws + WS_XC);
    const bf16_t* H = (const bf16_t*)(p->ws + WS_H); const bf16_t* WIN = (const bf16_t*)(p->ws + WS_WIN);
    const float* mods_l = (const float*)(p->ws + WS_MODS) + (size_t)l * 9 * 6144;
    if (ON(0) && k == 0) { if (l > 0) conv_weights(p, l, smem, 5248, 6272, 0); phase_norm(p, l, 0, l ? xl_in : p->x, l ? xc_in : p->ctx); }
    else if (ON(1) && (k == 1 || k == 4 || k == 7 || k == 10)) {
        const bf16_t* A = H; const bf16_t* Bt = WIN; int nM = 72, nN = 6; EpiBf<0> E{(bf16_t*)(p->ws + WS_QKV), 1536};
        if (k == 4 || k == 7) { Bt = WIN + (size_t)(1536 + (k == 7 ? 2560 : 0)) * 1024; nN = 10; E.O = (bf16_t*)(p->ws + WS_ZH); E.ldc = 2560; }
        if (k == 10) { A = WIN + (size_t)6656 * 1024; Bt = H; nM = 12; nN = 72; E.O = (bf16_t*)(p->ws + WS_UT); E.ldc = T; }
        int skp = 0; if (k == 10 && l == 1) { nN = 64; skp = 2; }
        run_gemm(smem, A, Bt, nM, nN, 1024, 0, skp, E);
    }
    else if (ON(2) && k == 2) phase_qkprep(p, l, smem);
    else if (ON(3) && k == 3) phase_attn(p, l, smem);
    else if (ON(5) && (k == 5 || k == 8)) phase_scan(p, l, k == 8 ? 1 : 0, smem);
    else if (ON(18) && (k == 18 || k == 19)) phase_scan_corr(p, smem);
    else if (ON(6) && (k == 6 || k == 9)) phase_readout(p, l, k == 9 ? 1 : 0);
    else if (ON(11) && k == 11) phase_hyena(p, l, smem);
    else if (ON(12) && k == 12) phase_transpose(p, smem);
    else if (ON(13) && k == 13) {
#pragma unroll 1
        for (int i = 0; i < 3; ++i) {
            EpiBf<1> Eg{(bf16_t*)(p->ws + WS_G), 1024};
            run_gemm(smem, H, WIN + (size_t)(9728 + i * 1024) * 1024, l ? 64 : 72, 4, 1024, 0, l, Eg);
            const bf16_t* A = (const bf16_t*)(p->ws + (i == 0 ? WS_ATT : (i == 1 ? WS_HG : WS_HY)));
            EpiMerge Em{(const bf16_t*)(p->ws + WS_G), (bf16_t*)(p->ws + WS_MRG), i == 0 ? 1 : 0};
            run_gemm(smem, A, (const bf16_t*)(p->ws + WS_WBR) + (size_t)i * 1024 * 1024, l ? 64 : 72, 4, 1024, 0, l, Em);
        }
    }
    else if (ON(14) && (k == 14 || k == 17)) {
        const bool first = (l == 0 && k == 14);
        EpiResid E{first ? p->x : (const float*)p->out, first ? p->ctx : (const float*)XC, p->out, XC, mods_l, k == 14 ? 2048 : 5120};
        const bf16_t* A = (const bf16_t*)(p->ws + (k == 14 ? WS_MRG : WS_HID4)); const bf16_t* Bt = (const bf16_t*)(p->ws + (k == 14 ? WS_WOUT : WS_WM2));
        run_gemm(smem, A, Bt, l ? 64 : 72, 4, k == 14 ? 1024 : 4096, 0, l, E);
        if (l == 0) { if (k == 14) conv_weights(p, 1, smem, 0, 3968, 32); else conv_weights(p, 1, smem, 4224, 5248, 32); }
    }
    else if (ON(15) && k == 15) { if (l == 0) conv_weights(p, 1, smem, 3968, 4224, 0); phase_norm(p, l, 1, p->out, XC); }
    else if (ON(16) && k == 16) { EpiBf<2> E{(bf16_t*)(p->ws + WS_HID4), 4096}; run_gemm(smem, H, (const bf16_t*)(p->ws + WS_WM1), l ? 64 : 72, 16, 1024, 0, l, E); }
}

__global__ void __launch_bounds__(512, 2) hybrid_flow_megakernel(Params p, int ph_lo, int ph_hi) {
    extern __shared__ __attribute__((aligned(16))) unsigned char smem[];
    cg::grid_group grid = cg::this_grid();
    volatile LAS unsigned* bst = (volatile LAS unsigned*)(smem + LDS_BYTES - 16);
    if (threadIdx.x < 4) bst[threadIdx.x] = 0u;
    __syncthreads();
    XcdBarrier bar = xcd_barrier_post((unsigned*)(p.ws + WS_CTL), bst);
#ifdef PROBE_MASK
    const int n_extra = PROBE_REP * __builtin_popcount(PROBE_MASK);
#else
    const int n_extra = 0;
#endif
    for (int it = ph_lo; it < ph_hi + n_extra; ++it) {
        int ph = it;
#ifdef PROBE_MASK
        if (it >= ph_hi) { int j = (it - ph_hi) % __builtin_popcount(PROBE_MASK), k = 0; for (;; ++k) if ((PROBE_MASK >> k) & 1) { if (j == 0) break; --j; } ph = 1 + PH_PER_LAYER + k; }
#endif
        PP pp = (PP)__builtin_amdgcn_kernarg_segment_ptr();
        asm volatile("" : "+s"(pp));
        run_phase(pp, ph, smem);
        if (it + 1 < ph_hi + n_extra) { if (ph_hi > (1 << 20)) grid.sync(); xcd_barrier(bar); }
    }
}

#ifndef N_LAUNCH_SPLIT
#define N_LAUNCH_SPLIT 0
#endif
extern "C" void kernel_launch(void* const* d_in, const int* in_sizes, int n_in, void* d_out, int out_size, void* d_ws, size_t ws_size, hipStream_t stream) {
    static int grid_blocks = 0;
    if (grid_blocks == 0) {
        if (n_in != 26 || ws_size < WS_END) { fprintf(stderr, "kernel_launch: n_in %d ws %zu need %zu\n", n_in, ws_size, (size_t)WS_END); grid_blocks = -1; return; }
        int dev = 0, cus = 0, per_cu = 0;
        hipGetDevice(&dev); hipDeviceGetAttribute(&cus, hipDeviceAttributeMultiprocessorCount, dev);
        if (hipFuncSetAttribute((const void*)hybrid_flow_megakernel, hipFuncAttributeMaxDynamicSharedMemorySize, LDS_BYTES) != hipSuccess) { fprintf(stderr, "kernel_launch: LDS attribute failed\n"); grid_blocks = -1; return; }
        if (hipOccupancyMaxActiveBlocksPerMultiprocessor(&per_cu, (const void*)hybrid_flow_megakernel, 512, LDS_BYTES) != hipSuccess || per_cu < 1) { fprintf(stderr, "kernel_launch: occupancy query failed (%d)\n", per_cu); grid_blocks = -1; return; }
        grid_blocks = cus * 1;
    }
    if (grid_blocks < 0) return;
    Params p{};
    const float** pp = (const float**)&p;
    for (int i = 0; i < 26; ++i) pp[i] = (const float*)d_in[i];
    p.out = (float*)d_out; p.ws = (unsigned char*)d_ws;
#if N_LAUNCH_SPLIT
    for (int ph = 0; ph < N_PHASES; ++ph) { int lo = ph, hi = ph + 1; void* args[] = {&p, &lo, &hi};
        hipLaunchCooperativeKernel((const void*)hybrid_flow_megakernel, dim3(grid_blocks), dim3(512), args, LDS_BYTES, stream); }
#else
    if (hipMemsetAsync((unsigned char*)d_ws + WS_CTL, 0, 16384, stream) != hipSuccess) { fprintf(stderr, "kernel_launch: memset failed\n"); return; }
    int lo = 0, hi = N_PHASES; void* args[] = {&p, &lo, &hi};
    hipError_t e = hipLaunchCooperativeKernel((const void*)hybrid_flow_megakernel, dim3(grid_blocks), dim3(512), args, LDS_BYTES, stream);
    if (e != hipSuccess) fprintf(stderr, "cooperative launch failed: %s (grid %d)\n", hipGetErrorString(e), grid_blocks);
#endif
}
```

```cpp
#include <hip/hip_runtime.h>
#include <hip/hip_bf16.h>
#include <hip/hip_cooperative_groups.h>
#include <cstdio>
#include <cstdint>
namespace cg = cooperative_groups;

__device__ __forceinline__ int otid() { int t = (int)threadIdx.x; asm volatile("" : "+v"(t)); return t; }

namespace pg8 {
#define PG8_LAS __attribute__((address_space(3)))
typedef unsigned short bf16_t;
typedef short bf16x8 __attribute__((ext_vector_type(8)));
typedef float f32x4 __attribute__((ext_vector_type(4)));
typedef unsigned u32x4 __attribute__((ext_vector_type(4)));
constexpr int BM = 256, BK = 64, HALF = 128, HTB = HALF * BK * 2  , STAGE_BYTES = 8 * HTB, NXCD = 8, WGM = 8;

__host__ __device__ __forceinline__ int lds_byte(int r, int c) { const int st = (r >> 4) * 2 + (c >> 5), rr = r & 15, cc = c & 31, ob = rr * 64 + cc * 2; return st * 1024 + (ob ^ (((ob >> 9) & 1) << 5)); }
__host__ __device__ __forceinline__ void stage_rc(int b, int& R, int& C) { const int st = b / 1024, sb = b % 1024, swz = sb ^ (((sb >> 9) & 1) << 5); R = (st >> 1) * 16 + swz / 64; C = (st & 1) * 32 + (swz % 64) / 2; }
__host__ __device__ __forceinline__ int perm32(int rho) { const int n = rho >> 4, i = rho & 15; return 8 * (i >> 2) + 4 * n + (i & 3); }

struct Unit { int pm, pn; };
struct Gemm { const bf16_t* A; const bf16_t* Bt; int M, N, K; };

struct StaticOrder {
    int nM, nN, nwg, G, c;
    __host__ __device__ void init(int M, int N, int G_, int c_) { nM = M / BM; nN = N / BM; nwg = nM * nN; G = G_; c = c_; }
    __host__ __device__ bool next(int i, Unit& u) const {
        const long L = (long)i * G + c; if (L >= nwg) return false;
        int wgid = (int)L; { const int q = nwg / NXCD, r = nwg % NXCD, xcd = wgid % NXCD, off = wgid / NXCD; wgid = (xcd < r ? xcd * (q + 1) : r * (q + 1) + (xcd - r) * q) + off; }
        const int nig = WGM * nN, gid = wgid / nig, fm = gid * WGM, gsz = (nM - fm) < WGM ? (nM - fm) : WGM;
        u.pm = fm + ((wgid % nig) % gsz); u.pn = (wgid % nig) / gsz; return true;
    }
    __device__ __forceinline__ void a_ready(const Unit&) const {}
    __device__ __forceinline__ void done(const Unit&) const {}
};
template <class Epi, class Sched, bool STAMP = false>
__device__ __forceinline__ void gemm_phase(PG8_LAS unsigned char* lds, const Gemm g, const Sched& S, const Epi& E, unsigned long long* stamps) {
    const int tid = otid(), wid = __builtin_amdgcn_readfirstlane(tid >> 6), lane = tid & 63, wr = wid >> 2, wc = wid & 3, fr = lane & 15, fq = lane >> 4;
    const int K = g.K, nt = K / BK;
    int ts_lo = 0, ts_hi = 0, nts = 0; const unsigned long long rt_entry = STAMP ? (unsigned long long)wall_clock64() : 0ull;
#define PG8_STAMP() do { if (STAMP && wid == 0 && nts < 64) { const unsigned long long _c = (unsigned long long)clock64(); \
        ts_lo = (lane == nts) ? (int)(unsigned)_c : ts_lo; ts_hi = (lane == nts) ? (int)(unsigned)(_c >> 32) : ts_hi; ++nts; } } while (0)
    PG8_STAMP();
    unsigned voffA[2], voffB[2];
#pragma unroll
    for (int i = 0; i < 2; ++i) { int R, C; stage_rc(tid * 16 + i * 8192, R, C); const int Rb = Epi::PERM ? ((R & ~31) + perm32(R & 31)) : R;
        voffA[i] = (unsigned)(R * K + C) * 2u; voffB[i] = (unsigned)(Rb * K + C) * 2u; }
    const size_t kstep = (size_t)(BK * 2);
    const size_t hstep = (size_t)HALF * K * 2;
    const size_t tstep = 2 * hstep;
    const unsigned ldsw = (unsigned)wid * 1024u;
    const int aoff = lds_byte(wr * 64 + fr, fq * 8), boff = lds_byte(wc * 32 + fr, fq * 8);
#define PG8_SA(b, h) (((b) * 2 + (h)) * HTB)
#define PG8_SB(b, h) ((4 + (b) * 2 + (h)) * HTB)
#define PG8_STAGE(bufoff, gbase, voff) do { _Pragma("unroll") for (int _i = 0; _i < 2; ++_i) \
        __builtin_amdgcn_global_load_lds((const unsigned*)((const char*)(gbase) + (voff)[_i]), (PG8_LAS unsigned*)(lds + (bufoff) + ldsw + _i * 8192), 16, 0, 0); } while (0)
#define PG8_LDA(dst, b, h) do { _Pragma("unroll") for (int m = 0; m < 4; ++m) _Pragma("unroll") for (int k = 0; k < 2; ++k) dst[m][k] = *(const PG8_LAS bf16x8*)(lds + PG8_SA(b, h) + aoff + m * 2048 + k * 1024); } while (0)
#define PG8_LDB(dst, b, h) do { _Pragma("unroll") for (int n = 0; n < 2; ++n) _Pragma("unroll") for (int k = 0; k < 2; ++k) dst[n][k] = *(const PG8_LAS bf16x8*)(lds + PG8_SB(b, h) + boff + n * 2048 + k * 1024); } while (0)
#define PG8_MMA(ai, bj, At, Bt) do { __builtin_amdgcn_s_setprio(1); _Pragma("unroll") for (int m = 0; m < 4; ++m) _Pragma("unroll") for (int n = 0; n < 2; ++n) _Pragma("unroll") for (int k = 0; k < 2; ++k) \
        acc[ai][bj][m][n] = __builtin_amdgcn_mfma_f32_16x16x32_bf16(Bt[n][k], At[m][k], acc[ai][bj][m][n], 0, 0, 0); __builtin_amdgcn_s_setprio(0); } while (0)
#define PG8_WAIT_V(n) asm volatile("s_waitcnt vmcnt(" #n ")" ::: "memory")
#define PG8_WAIT_L(n) asm volatile("s_waitcnt lgkmcnt(" #n ")" ::: "memory")
#define PG8_BAR __builtin_amdgcn_s_barrier()
#define PG8_SCHED __builtin_amdgcn_sched_barrier(0)
    Unit cur, nxt; int ui = 0;
    if (!S.next(0, cur)) return;
    f32x4 acc[2][2][4][2];
#pragma unroll
    for (int a = 0; a < 2; ++a)
#pragma unroll
        for (int b = 0; b < 2; ++b)
#pragma unroll
            for (int m = 0; m < 4; ++m)
#pragma unroll
                for (int n = 0; n < 2; ++n) acc[a][b][m][n] = (f32x4){0.f, 0.f, 0.f, 0.f};
    bf16x8 At[4][2], B0[2][2], B1[2][2];
    const char* cA = (const char*)g.A + (size_t)cur.pm * tstep; const char* cB = (const char*)g.Bt + (size_t)cur.pn * tstep;
    S.a_ready(cur);
    PG8_STAGE(PG8_SB(0, 0), cB, voffB); PG8_STAGE(PG8_SA(0, 0), cA, voffA); PG8_STAGE(PG8_SB(0, 1), cB + hstep, voffB); PG8_STAGE(PG8_SA(0, 1), cA + hstep, voffA);
    if (wr == 1) PG8_BAR;
    PG8_WAIT_V(4); PG8_BAR;
    PG8_STAGE(PG8_SB(1, 0), cB + kstep, voffB); PG8_STAGE(PG8_SA(1, 0), cA + kstep, voffA); PG8_STAGE(PG8_SB(1, 1), cB + hstep + kstep, voffB);
    PG8_WAIT_V(6); PG8_BAR;
    PG8_STAMP();
    for (;;) {
        const bool has_next = S.next(ui + 1, nxt);
        const char* nA = has_next ? (const char*)g.A + (size_t)nxt.pm * tstep : cA; const char* nB = has_next ? (const char*)g.Bt + (size_t)nxt.pn * tstep : cB;
        for (int t = 0; t < nt; t += 2) {
            const bool last = (t == nt - 2);
            const char* a1 = cA + (size_t)(t + 1) * kstep;
            const char* a2 = last ? nA : cA + (size_t)(t + 2) * kstep; const char* b2 = last ? nB : cB + (size_t)(t + 2) * kstep;
            const char* a3 = a2 + kstep; const char* b3 = b2 + kstep;
            if (last && has_next) S.a_ready(nxt);
            PG8_LDB(B0, 0, 0); PG8_SCHED; PG8_LDA(At, 0, 0); PG8_STAGE(PG8_SA(1, 1), a1 + hstep, voffA);
            PG8_WAIT_L(8); PG8_BAR; PG8_WAIT_L(0); PG8_MMA(0, 0, At, B0); PG8_BAR; PG8_SCHED;
            PG8_LDB(B1, 0, 1); PG8_STAGE(PG8_SB(0, 0), b2, voffB);
            PG8_BAR; PG8_WAIT_L(0); PG8_MMA(0, 1, At, B1); PG8_BAR;
            PG8_LDA(At, 0, 1); PG8_STAGE(PG8_SA(0, 0), a2, voffA);
            PG8_BAR; PG8_WAIT_L(0); PG8_MMA(1, 0, At, B0); PG8_BAR; PG8_SCHED;
            PG8_STAGE(PG8_SB(0, 1), b2 + hstep, voffB);
            PG8_WAIT_V(6); PG8_BAR; PG8_MMA(1, 1, At, B1); PG8_BAR;
            PG8_LDB(B0, 1, 0); PG8_SCHED; PG8_LDA(At, 1, 0); PG8_STAGE(PG8_SA(0, 1), a2 + hstep, voffA);
            PG8_WAIT_L(8); PG8_BAR; PG8_WAIT_L(0); PG8_MMA(0, 0, At, B0); PG8_BAR; PG8_SCHED;
            PG8_LDB(B1, 1, 1); PG8_STAGE(PG8_SB(1, 0), b3, voffB);
            PG8_BAR; PG8_WAIT_L(0); PG8_MMA(0, 1, At, B1); PG8_BAR;
            PG8_LDA(At, 1, 1); PG8_STAGE(PG8_SA(1, 0), a3, voffA);
            PG8_BAR; PG8_WAIT_L(0); PG8_MMA(1, 0, At, B0); PG8_BAR; PG8_SCHED;
            PG8_STAGE(PG8_SB(1, 1), b3 + hstep, voffB);
            PG8_WAIT_V(6); PG8_BAR; PG8_MMA(1, 1, At, B1); PG8_BAR;
        }
        PG8_STAMP();
        if constexpr (!Epi::AFTER_DRAIN) { E(acc, cur, wr, wc, fr, fq); S.done(cur); }
        PG8_STAMP();
        if (!has_next) break;
#pragma unroll
        for (int a = 0; a < 2; ++a)
#pragma unroll
            for (int b = 0; b < 2; ++b)
#pragma unroll
                for (int m = 0; m < 4; ++m)
#pragma unroll
                    for (int n = 0; n < 2; ++n) acc[a][b][m][n] = (f32x4){0.f, 0.f, 0.f, 0.f};
        cur = nxt; cA = nA; cB = nB; ++ui;
    }
    PG8_WAIT_V(0);
    if (wr == 0) PG8_BAR;
    PG8_BAR;
    if constexpr (Epi::AFTER_DRAIN) { E.fused(acc, cur, wr, wc, fr, fq, lds, wid, lane); S.done(cur); }
    PG8_STAMP();
    if (STAMP && wid == 0) { stamps[lane] = lane < nts ? (((unsigned long long)(unsigned)ts_hi << 32) | (unsigned)ts_lo) : 0ull;
        if (lane == 62) stamps[62] = rt_entry; if (lane == 63) stamps[63] = (unsigned long long)wall_clock64(); }
#undef PG8_STAMP
#undef PG8_SA
#undef PG8_SB
#undef PG8_STAGE
#undef PG8_LDA
#undef PG8_LDB
#undef PG8_MMA
#undef PG8_WAIT_V
#undef PG8_WAIT_L
#undef PG8_BAR
#undef PG8_SCHED
}
}

namespace att {
using bf16 = __hip_bfloat16;
constexpr int   D = 128, NW = 8, QBLK = 32, KVBLK = 64;
constexpr float SCALE = 0.088388347648318440f;
constexpr float THR = 8.f;
constexpr int SDEPTH = 2;
constexpr int LDQ = 1536, LDK = 1536, LDO = 1024;
constexpr size_t SHM_V = KVBLK * D * 2, SHM_K = KVBLK * D * 2, SHM_ATTN = 2 * SHM_V + 2 * SHM_K + NW * 64 * 4;
using bf16x8 = __attribute__((ext_vector_type(8))) short;
using s16x4  = __attribute__((ext_vector_type(4))) short;
using f32x16 = __attribute__((ext_vector_type(16))) float;
using f32x8  = __attribute__((ext_vector_type(8))) float;
using u32x4  = __attribute__((ext_vector_type(4))) unsigned;
#define KSWZ(row, colB) ((row) * 256 + ((colB) ^ (((row) & 7) << 4)))
#define SBAR() __builtin_amdgcn_sched_barrier(0)
__device__ __forceinline__ int crow(int r, int hi) { return (r & 3) + 8 * (r >> 2) + 4 * hi; }
__device__ __forceinline__ unsigned cvtpk(float lo, float hi) {
  unsigned r; asm volatile("v_cvt_pk_bf16_f32 %0, %1, %2" : "=v"(r) : "v"(lo), "v"(hi)); return r;
}
template <typename TIn> struct Stage;
template <> struct Stage<bf16>  { using T = bf16x8;
  __device__ static __forceinline__ T ld8(const bf16* p) { return *reinterpret_cast<const bf16x8*>(p); }
  __device__ static __forceinline__ bf16x8 tobf(T x) { return x; } };
template <> struct Stage<float> { using T = f32x8;
  __device__ static __forceinline__ T ld8(const float* p) { return *reinterpret_cast<const f32x8*>(p); }
  __device__ static __forceinline__ bf16x8 tobf(T x) {
    u32x4 w = {cvtpk(x[0], x[1]), cvtpk(x[2], x[3]), cvtpk(x[4], x[5]), cvtpk(x[6], x[7])}; return *reinterpret_cast<bf16x8*>(&w); } };

__device__ __forceinline__ void partialSM(f32x16& p0, f32x16& p1, float& m_reg, float& mn, float& alpha) {
  constexpr float C = SCALE * 1.4426950408889634f;
  float pmax = p0[0]; for (int r = 1; r < 16; ++r) pmax = fmaxf(pmax, p0[r]); for (int r = 0; r < 16; ++r) pmax = fmaxf(pmax, p1[r]);
  { auto rr = __builtin_amdgcn_permlane32_swap(__float_as_uint(pmax), __float_as_uint(pmax), false, false);
    pmax = fmaxf(__uint_as_float(rr[0]), __uint_as_float(rr[1])); }
  if (__builtin_expect(__all(pmax - m_reg <= THR / SCALE), 1)) { mn = m_reg; alpha = 1.f; }
  else { mn = fmaxf(m_reg, pmax); alpha = __builtin_amdgcn_exp2f((m_reg - mn) * C); m_reg = mn; }
  float mnC = -mn * C;
  for (int r = 0; r < 16; ++r) p0[r] = fmaf(p0[r], C, mnC); for (int r = 0; r < 16; ++r) p1[r] = fmaf(p1[r], C, mnC);
  for (int r = 0; r < 16; ++r) p0[r] = __builtin_amdgcn_exp2f(p0[r]);
}
__device__ __forceinline__ void finishSM(f32x16& p0, f32x16& p1, float alpha, float& l_reg, bf16x8& pa0, bf16x8& pa1, bf16x8& pa2, bf16x8& pa3) {
  for (int r = 0; r < 16; ++r) p1[r] = __builtin_amdgcn_exp2f(p1[r]);
  float ps = 0; for (int r = 0; r < 16; ++r) ps += p0[r]; for (int r = 0; r < 16; ++r) ps += p1[r];
  { auto rr = __builtin_amdgcn_permlane32_swap(__float_as_uint(ps), __float_as_uint(ps), false, false);
    ps = __uint_as_float(rr[0]) + __uint_as_float(rr[1]); }
  l_reg = l_reg * alpha + ps;
#define PK4(P, BASE, OUT) do { unsigned a0 = cvtpk(P[BASE + 0], P[BASE + 1]), a1 = cvtpk(P[BASE + 2], P[BASE + 3]);   \
    unsigned b0 = cvtpk(P[BASE + 4], P[BASE + 5]), b1 = cvtpk(P[BASE + 6], P[BASE + 7]);                              \
    auto r0 = __builtin_amdgcn_permlane32_swap(a0, b0, false, false); auto r1 = __builtin_amdgcn_permlane32_swap(a1, b1, false, false); \
    u32x4 w = {r0[0], r1[0], r0[1], r1[1]}; OUT = *reinterpret_cast<bf16x8*>(&w); } while (0)
  PK4(p0, 0, pa0); PK4(p0, 8, pa1); PK4(p1, 0, pa2); PK4(p1, 8, pa3);
#undef PK4
}
__device__ __forceinline__ void qkt(f32x16& p0, f32x16& p1, const bf16* Ks, const bf16x8* qr, int r32, int hi) {
  p0 = f32x16{}; p1 = f32x16{};
  for (int d0 = 0; d0 < 8; ++d0) { int cb = (d0 * 16 + hi * 8) * 2;
    bf16x8 b0 = *reinterpret_cast<const bf16x8*>((const char*)Ks + KSWZ(r32, cb));
    bf16x8 b1 = *reinterpret_cast<const bf16x8*>((const char*)Ks + KSWZ(32 + r32, cb));
    p0 = __builtin_amdgcn_mfma_f32_32x32x16_bf16(b0, qr[d0], p0, 0, 0, 0);
    p1 = __builtin_amdgcn_mfma_f32_32x32x16_bf16(b1, qr[d0], p1, 0, 0, 0); }
}
__device__ __forceinline__ int v_st(int k, int c) { const int kk = (k & ~0xC) | ((k & 4) << 1) | ((k & 8) >> 1); return ((kk >> 3) * 4 + (c >> 5)) * 512 + ((kk & 7) * 32 + (c & 31)) * 2; }
__device__ __forceinline__ int v_rd_base(int lane) { return ((lane & 3) << 3) | (((lane >> 2) & 3) << 6) | (((lane >> 4) & 1) << 5) | (((lane >> 5) & 1) << 8); }
constexpr int v_rd_off(int d0, int ks, int half) { return d0 * 512 + ks * 4096 + half * 2048; }
template <int OFF> __device__ __forceinline__ s16x4 tr_read(int vb) {
  s16x4 r; asm volatile("ds_read_b64_tr_b16 %0, %1 offset:%2" : "=&v"(r) : "v"(vb), "i"(OFF) : "memory"); return r;
}
template <int D0> __device__ __forceinline__ void pv_one(f32x16& od, int vb, bf16x8 pa0, bf16x8 pa1, bf16x8 pa2, bf16x8 pa3) {
  const s16x4 l0 = tr_read<v_rd_off(D0, 0, 0)>(vb), h0 = tr_read<v_rd_off(D0, 0, 1)>(vb), l1 = tr_read<v_rd_off(D0, 1, 0)>(vb), h1 = tr_read<v_rd_off(D0, 1, 1)>(vb);
  const s16x4 l2 = tr_read<v_rd_off(D0, 2, 0)>(vb), h2 = tr_read<v_rd_off(D0, 2, 1)>(vb), l3 = tr_read<v_rd_off(D0, 3, 0)>(vb), h3 = tr_read<v_rd_off(D0, 3, 1)>(vb);
  asm volatile("s_waitcnt lgkmcnt(0)" ::: "memory"); SBAR();
#define PK(L, H) (bf16x8){L[0], L[1], L[2], L[3], H[0], H[1], H[2], H[3]}
  od = __builtin_amdgcn_mfma_f32_32x32x16_bf16(pa0, PK(l0, h0), od, 0, 0, 0);
  od = __builtin_amdgcn_mfma_f32_32x32x16_bf16(pa1, PK(l1, h1), od, 0, 0, 0);
  od = __builtin_amdgcn_mfma_f32_32x32x16_bf16(pa2, PK(l2, h2), od, 0, 0, 0);
  od = __builtin_amdgcn_mfma_f32_32x32x16_bf16(pa3, PK(l3, h3), od, 0, 0, 0);
#undef PK
}
__device__ __forceinline__ void pv_d0(f32x16* o, int vb, bf16x8 pa0, bf16x8 pa1, bf16x8 pa2, bf16x8 pa3) {
  pv_one<0>(o[0], vb, pa0, pa1, pa2, pa3); pv_one<1>(o[1], vb, pa0, pa1, pa2, pa3); pv_one<2>(o[2], vb, pa0, pa1, pa2, pa3); pv_one<3>(o[3], vb, pa0, pa1, pa2, pa3);
}

template <typename TQ>
__device__ __forceinline__ void attn_dense_body(const TQ* __restrict__ Qb, const bf16* __restrict__ Kh, const bf16* __restrict__ Vh,
                                                unsigned short* __restrict__ Ob, int seq, char* lds) {
  using St = Stage<bf16>; using SQ = Stage<TQ>;
  const int tid = otid(), wid = tid >> 6, lane = tid & 63, r32 = lane & 31, hi = lane >> 5;
  bf16* V_lds = (bf16*)lds; bf16* K_lds = (bf16*)(lds + 2 * SHM_V);
  float* ws = (float*)(lds + 2 * SHM_V + 2 * SHM_K) + wid * 64; float* li_l = ws; float* al_l = ws + 32;
  float m_reg = -1e30f, l_reg = 0; f32x16 o[4] = {}; bf16x8 qr[8];
  const TQ* Qw = Qb + (long)(wid * QBLK + r32) * LDQ + hi * 8;
#pragma unroll
  for (int d0 = 0; d0 < 8; ++d0) qr[d0] = SQ::tobf(SQ::ld8(Qw + d0 * 16));
  const int sr = tid >> 4, sc = (tid & 15) * 8, vst0 = v_st(sr, sc), vst1 = v_st(32 + sr, sc);
  const int vb0 = (int)(uintptr_t)V_lds + v_rd_base(lane);
  struct { typename St::T vs0, vs1, ks0, ks1; } sr_[SDEPTH];
#define SLOAD(i, k0) do { sr_[i].vs0 = St::ld8(&Vh[(long)((k0) + sr) * LDK + sc]); sr_[i].vs1 = St::ld8(&Vh[(long)((k0) + 32 + sr) * LDK + sc]); \
    sr_[i].ks0 = St::ld8(&Kh[(long)((k0) + sr) * LDK + sc]); sr_[i].ks1 = St::ld8(&Kh[(long)((k0) + 32 + sr) * LDK + sc]); } while (0)
#define SWRITE(b, i) do { *(bf16x8*)((char*)V_lds + (b) * SHM_V + vst0) = St::tobf(sr_[i].vs0);          \
    *(bf16x8*)((char*)V_lds + (b) * SHM_V + vst1) = St::tobf(sr_[i].vs1); int kc = sc * 2;               \
    *(bf16x8*)((char*)K_lds + (b) * SHM_K + KSWZ(sr, kc)) = St::tobf(sr_[i].ks0);                       \
    *(bf16x8*)((char*)K_lds + (b) * SHM_K + KSWZ(32 + sr, kc)) = St::tobf(sr_[i].ks1); } while (0)
#define SWAIT() do { if constexpr (SDEPTH == 2) asm volatile("s_waitcnt vmcnt(4)" ::: "memory"); else asm volatile("s_waitcnt vmcnt(0)" ::: "memory"); } while (0)
#define RESC(a) do { if (__any((a) < 1.f)) { if (hi == 0) al_l[r32] = (a); asm volatile("s_waitcnt lgkmcnt(0)" ::: "memory"); \
    for (int d = 0; d < 4; ++d) for (int r = 0; r < 16; ++r) o[d][r] *= al_l[crow(r, hi)]; } } while (0)
  f32x16 pA0, pA1, pB0, pB1; float mnA, mnB, alA, alB; bf16x8 pa0, pa1, pa2, pa3; const int NT = seq / KVBLK;
  constexpr int SE = 0, SO = SDEPTH - 1;
  SLOAD(SE, 0); asm volatile("s_waitcnt vmcnt(0)" ::: "memory"); SWRITE(0, SE); __syncthreads();
  qkt(pA0, pA1, K_lds, qr, r32, hi); partialSM(pA0, pA1, m_reg, mnA, alA);
  SLOAD(SO, KVBLK); if constexpr (SDEPTH == 2) { if (2 < NT) SLOAD(SE, 2 * KVBLK); }
  SWAIT(); SWRITE(1, SO); __syncthreads();
  for (int j = 1; j + 1 < NT; j += 2) {
    SBAR(); qkt(pB0, pB1, (bf16*)((char*)K_lds + SHM_K), qr, r32, hi);
    finishSM(pA0, pA1, alA, l_reg, pa0, pa1, pa2, pa3); SBAR();
    SLOAD(SO, (j + SDEPTH) * KVBLK); SBAR();
    pv_d0(o, vb0, pa0, pa1, pa2, pa3); partialSM(pB0, pB1, m_reg, mnB, alB);
    __syncthreads(); SWAIT(); SWRITE(0, SE);
    RESC(alB); __syncthreads();
    SBAR(); qkt(pA0, pA1, K_lds, qr, r32, hi);
    finishSM(pB0, pB1, alB, l_reg, pa0, pa1, pa2, pa3); SBAR();
    if (SDEPTH == 1 || j + 3 < NT) SLOAD(SE, (j + 1 + SDEPTH) * KVBLK); SBAR();
    pv_d0(o, vb0 + (int)SHM_V, pa0, pa1, pa2, pa3); partialSM(pA0, pA1, m_reg, mnA, alA);
    __syncthreads(); SWAIT(); SWRITE(1, SO);
    RESC(alA); __syncthreads();
  }
  SBAR(); qkt(pB0, pB1, (bf16*)((char*)K_lds + SHM_K), qr, r32, hi);
  finishSM(pA0, pA1, alA, l_reg, pa0, pa1, pa2, pa3); SBAR();
  pv_d0(o, vb0, pa0, pa1, pa2, pa3); partialSM(pB0, pB1, m_reg, mnB, alB);
  __syncthreads(); RESC(alB);
  finishSM(pB0, pB1, alB, l_reg, pa0, pa1, pa2, pa3); SBAR();
  pv_d0(o, vb0 + (int)SHM_V, pa0, pa1, pa2, pa3);
  if (hi == 0) li_l[r32] = l_reg; asm volatile("s_waitcnt lgkmcnt(0)" ::: "memory");
  float rli[16];
#pragma unroll
  for (int r = 0; r < 16; ++r) rli[r] = __builtin_amdgcn_rcpf(li_l[crow(r, hi)]);
  unsigned short* Ow = Ob + (long)(wid * QBLK) * LDO;
#pragma unroll
  for (int r = 0; r < 16; ++r) { int orow = crow(r, hi);
    for (int d0 = 0; d0 < 4; ++d0) Ow[(long)orow * LDO + d0 * 32 + r32] = (unsigned short)(cvtpk(o[d0][r] * rli[r], 0.f) & 0xffffu); }
#undef SLOAD
#undef SWRITE
#undef SWAIT
#undef RESC
}
}

using pg8::bf16_t; using pg8::bf16x8; using pg8::f32x4; using pg8::u32x4; using pg8::Unit;
typedef unsigned u32x2 __attribute__((ext_vector_type(2)));
constexpr int NB = 8, RPB = 2304  , T = NB * RPB, NIN = 12800;
constexpr size_t AL(size_t x) { return (x + 255) & ~(size_t)255; }
constexpr size_t SZ_TD   = (size_t)T * 1024 * 2;
constexpr size_t WS_MODS = 0;
constexpr size_t WS_HIDF = WS_MODS + AL((size_t)2 * 9 * 6144 * 4);
constexpr size_t WS_XC   = WS_HIDF + AL((size_t)2 * 2304 * 64 * 4);
constexpr size_t WS_WIN  = WS_XC + AL((size_t)8 * 256 * 1024 * 4);
constexpr size_t WS_WBR  = WS_WIN + (size_t)NIN * 1024 * 2;
constexpr size_t WS_WOUT = WS_WBR + (size_t)3 * 1024 * 1024 * 2;
constexpr size_t WS_WM1  = WS_WOUT + (size_t)1024 * 1024 * 2;
constexpr size_t WS_WM2  = WS_WM1 + (size_t)4096 * 1024 * 2;
constexpr size_t WS_H    = WS_WM2 + (size_t)4096 * 1024 * 2;
constexpr size_t WS_ARENA = WS_H + SZ_TD;
constexpr size_t WS_ATT = WS_ARENA, WS_HG = WS_ARENA + SZ_TD, WS_S = WS_ARENA + 2 * SZ_TD;
constexpr size_t WS_QKV = WS_S;
constexpr size_t WS_ZH  = WS_S;
constexpr size_t WS_OFB = WS_S + (size_t)T * 2560 * 2;
constexpr size_t WS_UT  = WS_S;
constexpr size_t WS_G = WS_S, WS_HY = WS_S + SZ_TD, WS_MRG = WS_S + 2 * SZ_TD;
constexpr size_t WS_HID4 = WS_ARENA;
constexpr size_t WS_QS  = AL(WS_OFB + (size_t)2 * T * 512 * 2);
constexpr size_t WS_ST0 = WS_QS + (size_t)64 * 1152 * 128 * 2;
constexpr size_t WS_CTL = AL(WS_ST0 + (size_t)64 * 2 * 64 * 128 * 4);
constexpr size_t WS_END = WS_CTL + 16384;
static_assert(WS_END <= (size_t)333735424, "workspace");
constexpr int LDS_BYTES = 147456;

struct Params {
    const float *x, *c, *ctx, *c_ctx, *ada_w, *ada_b, *norm1_g, *norm2_g, *w_in, *q_norm_g, *k_norm_g, *hg_lb_raw, *hg_norm_g, *hy_short_w, *hy_short_b,
        *hy_filt_w1, *hy_filt_b1, *hy_filt_w2, *hy_filt_b2, *hy_filt_w3, *hy_freq, *hy_bias, *w_branch, *w_out, *w_mlp1, *w_mlp2;
    float* out; unsigned char* ws;
};
typedef const __attribute__((address_space(4))) Params* PP;

__device__ __forceinline__ unsigned pk2(float lo, float hi) { unsigned r; asm volatile("v_cvt_pk_bf16_f32 %0, %1, %2" : "=v"(r) : "v"(lo), "v"(hi)); return r; }
__device__ __forceinline__ bf16_t f2bf(float x) { return (bf16_t)(pk2(x, 0.f) & 0xffffu); }
__device__ __forceinline__ bf16_t f2bf_sw(float x) { const float y = x + 0.f; return (bf16_t)(pk2(y, 0.f) & 0xffffu); }
__device__ __forceinline__ float bf2f(bf16_t v) { return __uint_as_float(((unsigned)v) << 16); }
__device__ __forceinline__ float wave_sum(float v) {
#pragma unroll
    for (int o = 32; o > 0; o >>= 1) v += __shfl_xor(v, o);
    return v;
}

#define LAS __attribute__((address_space(3)))
#define XB_TMO      128
#define XB_XCNT(j)  (256  + 64 * (j))
#define XB_XSUB(j)  (1280 + 64 * (j))
#define XB_XGEN(j)  (2304 + 64 * (j))
#define XB_TOP      3328
#define XB_TOPGEN   3392
#define XCD_BAR_WORDS 3456
#define XB_SPIN_CAP (1u << 18)

__device__ __forceinline__ unsigned xb_ld(unsigned* p)              { return __hip_atomic_load(p, __ATOMIC_RELAXED, __HIP_MEMORY_SCOPE_AGENT); }
__device__ __forceinline__ unsigned xb_add(unsigned* p, unsigned v) { return __hip_atomic_fetch_add(p, v, __ATOMIC_RELAXED, __HIP_MEMORY_SCOPE_AGENT); }
__device__ __forceinline__ unsigned xb_xcc_id() { return (unsigned)__builtin_amdgcn_s_getreg((3 << 11) | 20) & 0xFu; }
#define XB_SPIN(cond, bar) do { unsigned _sp = 0; while (cond) { __builtin_amdgcn_s_sleep(1); \
    if ((++_sp & 255u) == 0u) { if (xb_ld(&(bar)[XB_TMO])) break; if (_sp > XB_SPIN_CAP) { atomicAdd(&(bar)[XB_TMO], 1u); break; } } } } while (0)

struct XcdBarrier {
    unsigned* bar; unsigned x;
    volatile LAS unsigned* st;
};

__device__ __forceinline__ XcdBarrier xcd_barrier_post(unsigned* bar, volatile LAS unsigned* st) {
    XcdBarrier b; b.bar = bar; b.x = xb_xcc_id(); b.st = st;
    if (threadIdx.x == 0) (void)xb_add(&bar[XB_XCNT(b.x)], 1u);
    return b;
}
__device__ __forceinline__ void xcd_barrier_complete(unsigned* bar, unsigned x, unsigned& nloc, unsigned& nx) {
    const unsigned G = gridDim.x * gridDim.y * gridDim.z;
    unsigned sum, cnt, mine, sp = 0u;
    for (;;) {
        sum = 0u; cnt = 0u; mine = 0u;
#pragma unroll
        for (unsigned j = 0; j < 16; ++j) { const unsigned c = xb_ld(&bar[XB_XCNT(j)]); sum += c; cnt += (c > 0u) ? 1u : 0u; mine = (j == x) ? c : mine; }
        if (sum == G) break;
        __builtin_amdgcn_s_sleep(1);
        if ((++sp & 255u) == 0u) { if (xb_ld(&bar[XB_TMO])) break; if (sp > XB_SPIN_CAP) { atomicAdd(&bar[XB_TMO], 1u); break; } }
    }
    nloc = mine > 0u ? mine : 1u; nx = cnt > 0u ? cnt : 1u;
}

__device__ __forceinline__ void xcd_barrier(const XcdBarrier& b) {
    asm volatile("s_waitcnt vmcnt(0)" ::: "memory");
    __syncthreads();
    if (threadIdx.x == 0) {
        unsigned* bar = b.bar;
        __builtin_amdgcn_s_waitcnt(0);
        unsigned nloc = b.st[0], nx = b.st[1];
        if (nloc == 0u) { xcd_barrier_complete(bar, b.x, nloc, nx); b.st[0] = nloc; b.st[1] = nx; }
        const unsigned old = xb_add(&bar[XB_XSUB(b.x)], 1u);
        const unsigned gen = old / nloc;
        if (old + 1u == (gen + 1u) * nloc) {
            __builtin_amdgcn_fence(__ATOMIC_RELEASE, "agent");
            asm volatile("s_waitcnt vmcnt(0)" ::: "memory");
            const unsigned og = xb_add(&bar[XB_TOP], 1u);
            const unsigned tg = og / nx;
            if (og + 1u == (tg + 1u) * nx) xb_add(&bar[XB_TOPGEN], 1u);
            else XB_SPIN(xb_ld(&bar[XB_TOPGEN]) == tg, bar);
            __builtin_amdgcn_fence(__ATOMIC_ACQUIRE, "agent");
            xb_add(&bar[XB_XGEN(b.x)], 1u);
            asm volatile("s_waitcnt vmcnt(0)" ::: "memory");
        } else {
            XB_SPIN(xb_ld(&bar[XB_XGEN(b.x)]) == gen, bar);
            __builtin_amdgcn_fence(__ATOMIC_ACQUIRE, "agent");
            asm volatile("s_waitcnt vmcnt(0)" ::: "memory");
        }
    }
    __syncthreads();
}

struct Sched {
    int nM, nN, nwg, G, c, skip;
    __device__ __forceinline__ void init(int nM_, int nN_, int G_, int c_, int skip_) { nM = nM_; nN = nN_; nwg = nM_ * nN_; G = G_; c = c_; skip = skip_; }
    __device__ __forceinline__ bool next(int i, Unit& u) const {
        const long L = (long)i * G + c; if (L >= nwg) return false;
        int wgid = (int)L; { const int q = nwg / 8, r = nwg % 8, xcd = wgid % 8, off = wgid / 8; wgid = (xcd < r ? xcd * (q + 1) : r * (q + 1) + (xcd - r) * q) + off; }
        const int nig = 8 * nN, gid = wgid / nig, fm = gid * 8, gsz = (nM - fm) < 8 ? (nM - fm) : 8;
        u.pm = fm + ((wgid % nig) % gsz); u.pn = (wgid % nig) / gsz;
        if (skip == 1) u.pm += u.pm / 8 + 1;
        if (skip == 2) u.pn += u.pn / 8 + 1;
        return true;
    }
    __device__ __forceinline__ void a_ready(const Unit&) const {}
    __device__ __forceinline__ void done(const Unit&) const {}
};

template <int ACT  > struct EpiBf {
    static constexpr bool PERM = true, AFTER_DRAIN = false;
    bf16_t* O; int ldc;
    __device__ __forceinline__ void operator()(const f32x4 (&acc)[2][2][4][2], const Unit& u, int wr, int wc, int fr, int fq) const {
        const int row0 = u.pm * 256 + wr * 64 + fr, col0 = u.pn * 256 + wc * 32 + 8 * fq;
#pragma unroll
        for (int ai = 0; ai < 2; ++ai)
#pragma unroll
            for (int m = 0; m < 4; ++m) { bf16_t* rowp = O + (size_t)(row0 + ai * 128 + m * 16) * ldc + col0;
#pragma unroll
                for (int bj = 0; bj < 2; ++bj) { f32x4 v0 = acc[ai][bj][m][0], v1 = acc[ai][bj][m][1];
                    if (ACT == 0) {
#pragma unroll
                        for (int j = 0; j < 4; ++j) { v0[j] = v0[j] + 0.f; v1[j] = v1[j] + 0.f; } }
                    if (ACT == 1) {
#pragma unroll
                        for (int j = 0; j < 4; ++j) { v0[j] = __builtin_amdgcn_rcpf(1.f + __expf(-v0[j])) + 0.f; v1[j] = __builtin_amdgcn_rcpf(1.f + __expf(-v1[j])) + 0.f; } }
                    if (ACT == 2) {
#pragma unroll
                        for (int j = 0; j < 4; ++j) { float a = fmaxf(v0[j], 0.f), b = fmaxf(v1[j], 0.f); v0[j] = a * a; v1[j] = b * b; } }
                    u32x4 w; w.x = pk2(v0[0], v0[1]); w.y = pk2(v0[2], v0[3]); w.z = pk2(v1[0], v1[1]); w.w = pk2(v1[2], v1[3]);
                    *(u32x4*)(rowp + bj * 128) = w; } }
    }
};
struct EpiMerge {
    static constexpr bool PERM = true, AFTER_DRAIN = false;
    const bf16_t* G; bf16_t* MRG; int first;
    __device__ __forceinline__ void operator()(const f32x4 (&acc)[2][2][4][2], const Unit& u, int wr, int wc, int fr, int fq) const {
        const int row0 = u.pm * 256 + wr * 64 + fr, col0 = u.pn * 256 + wc * 32 + 8 * fq;
#pragma unroll
        for (int ai = 0; ai < 2; ++ai)
#pragma unroll
            for (int m = 0; m < 4; ++m) { const size_t ro = (size_t)(row0 + ai * 128 + m * 16) * 1024 + col0;
#pragma unroll
                for (int bj = 0; bj < 2; ++bj) {
                    const u32x4 g = *(const u32x4*)(G + ro + bj * 128);
                    u32x4 o = {0u, 0u, 0u, 0u}; if (!first) o = *(const u32x4*)(MRG + ro + bj * 128);
                    float r[8];
#pragma unroll
                    for (int j = 0; j < 4; ++j) {
                        const float a0 = (j < 2 ? acc[ai][bj][m][0][2 * j] : acc[ai][bj][m][1][2 * j - 4]), a1 = (j < 2 ? acc[ai][bj][m][0][2 * j + 1] : acc[ai][bj][m][1][2 * j - 3]);
                        r[2 * j]     = __uint_as_float(o[j] << 16) + __uint_as_float(g[j] << 16) * a0;
                        r[2 * j + 1] = __uint_as_float(o[j] & 0xffff0000u) + __uint_as_float(g[j] & 0xffff0000u) * a1; }
                    u32x4 w; w.x = pk2(r[0], r[1]); w.y = pk2(r[2], r[3]); w.z = pk2(r[4], r[5]); w.w = pk2(r[6], r[7]);
                    *(u32x4*)(MRG + ro + bj * 128) = w; } }
    }
};
struct EpiResid {
    static constexpr bool PERM = false, AFTER_DRAIN = false;
    float* x_lat; float* x_ctx; const float* mods_l; int goff;
    __device__ __forceinline__ void operator()(const f32x4 (&acc)[2][2][4][2], const Unit& u, int wr, int wc, int fr, int fq) const {
        const int b = u.pm / 9, pt = u.pm % 9;
        float* xp; const float* gate;
        if (pt == 0) { xp = x_ctx + (size_t)b * 256 * 1024; gate = mods_l + 8 * 6144 + goff; }
        else { xp = x_lat + ((size_t)b * 2048 + (size_t)(pt - 1) * 256) * 1024; gate = mods_l + b * 6144 + goff; }
        const int lr0 = wr * 64 + fr, col0 = u.pn * 256 + wc * 32 + 4 * fq;
#pragma unroll
        for (int ai = 0; ai < 2; ++ai)
#pragma unroll
            for (int m = 0; m < 4; ++m) { const unsigned ro = (unsigned)(lr0 + ai * 128 + m * 16) * 1024u + (unsigned)col0;
                __builtin_amdgcn_sched_barrier(0);
#pragma unroll
                for (int bj = 0; bj < 2; ++bj)
#pragma unroll
                    for (int n = 0; n < 2; ++n) { const f32x4 xi = *(const f32x4*)(xp + ro + bj * 128 + n * 16); const f32x4 gq = *(const f32x4*)(gate + col0 + bj * 128 + n * 16);
                        *(f32x4*)(xp + ro + bj * 128 + n * 16) = xi + gq * acc[ai][bj][m][n]; } }
    }
};

template <class Epi>
__device__ __forceinline__ void run_gemm(unsigned char* smem, const bf16_t* A, const bf16_t* Bt, int nM, int nN, int K, int rot, int skip, const Epi& E) {
    pg8::Gemm g{A, Bt, nM * 256, nN * 256, K};
    Sched S; S.init(nM, nN, (int)gridDim.x, (int)((blockIdx.x + (unsigned)rot) % gridDim.x), skip);
    pg8::gemm_phase<Epi, Sched, false>((PG8_LAS unsigned char*)smem, g, S, E, nullptr);
}

__device__ __forceinline__ int mapcol(int n) {
    if (n < 1536 || n >= 6656) return n;
    const int x = n - 1536, hh = x / 2560, y = x % 2560, role = y / 512, j = y % 512;
    return 1536 + role * 1024 + hh * 512 + j;
}
__device__ __forceinline__ void conv_tile_desc(PP p, int l, int g, const float*& src, int& ld, int& col0, int& K, int& k0, int& drow0, bf16_t*& dst) {
    if (g < 3200) { const int nt = g >> 4, kt = g & 15; src = p->w_in + (size_t)l * 1024 * NIN; ld = NIN; drow0 = nt * 64; col0 = mapcol(drow0); K = 1024; k0 = kt * 64; dst = (bf16_t*)(p->ws + WS_WIN); }
    else if (g < 3968) { const int q = g - 3200, i = q >> 8, r = q & 255, nt = r >> 4, kt = r & 15; src = p->w_branch + ((size_t)l * 3 + i) * 1024 * 1024; ld = 1024; drow0 = nt * 64; col0 = drow0; K = 1024; k0 = kt * 64; dst = (bf16_t*)(p->ws + WS_WBR) + (size_t)i * 1024 * 1024; }
    else if (g < 4224) { const int q = g - 3968, nt = q >> 4, kt = q & 15; src = p->w_out + (size_t)l * 1024 * 1024; ld = 1024; drow0 = nt * 64; col0 = drow0; K = 1024; k0 = kt * 64; dst = (bf16_t*)(p->ws + WS_WOUT); }
    else if (g < 5248) { const int q = g - 4224, nt = q >> 4, kt = q & 15; src = p->w_mlp1 + (size_t)l * 1024 * 4096; ld = 4096; drow0 = nt * 64; col0 = drow0; K = 1024; k0 = kt * 64; dst = (bf16_t*)(p->ws + WS_WM1); }
    else { const int q = g - 5248, nt = q >> 6, kt = q & 63; src = p->w_mlp2 + (size_t)l * 4096 * 1024; ld = 1024; drow0 = nt * 64; col0 = drow0; K = 4096; k0 = kt * 64; dst = (bf16_t*)(p->ws + WS_WM2); }
}
__device__ void conv_weights(PP p, int l, unsigned char* smem, int g_lo, int g_hi, int b_lo) {
    float* tiles = (float*)smem;
    const int tid = otid();
    if ((int)blockIdx.x < b_lo) return;
    for (int g0 = g_lo + ((int)blockIdx.x - b_lo) * 4; g0 < g_hi; g0 += ((int)gridDim.x - b_lo) * 4) {
        float4 a[4], b[4];
#pragma unroll
        for (int q = 0; q < 4; ++q) { const int g = g0 + q; if (g < g_hi) {
            const float* src; int ld, col0, K, k0, drow0; bf16_t* dst; conv_tile_desc(p, l, g, src, ld, col0, K, k0, drow0, dst);
            const int kk = tid >> 4, n4 = (tid & 15) * 4;
            a[q] = *(const float4*)(src + (size_t)(k0 + kk) * ld + col0 + n4); b[q] = *(const float4*)(src + (size_t)(k0 + kk + 32) * ld + col0 + n4); } }
#pragma unroll
        for (int q = 0; q < 4; ++q) { if (g0 + q < g_hi) { const int kk = tid >> 4, n4 = (tid & 15) * 4; float* tile = tiles + q * 64 * 65;
            float* t0 = tile + kk * 65 + n4; t0[0] = a[q].x; t0[1] = a[q].y; t0[2] = a[q].z; t0[3] = a[q].w;
            float* t1 = tile + (kk + 32) * 65 + n4; t1[0] = b[q].x; t1[1] = b[q].y; t1[2] = b[q].z; t1[3] = b[q].w; } }
        __syncthreads();
#pragma unroll
        for (int q = 0; q < 4; ++q) { const int g = g0 + q; if (g < g_hi) {
            const float* src; int ld, col0, K, k0, drow0; bf16_t* dst; conv_tile_desc(p, l, g, src, ld, col0, K, k0, drow0, dst);
            const float* tile = tiles + q * 64 * 65; const int n = tid >> 3, k8 = (tid & 7) * 8; float v[8];
#pragma unroll
            for (int j = 0; j < 8; ++j) v[j] = tile[(k8 + j) * 65 + n];
            u32x4 w; w.x = pk2(v[0], v[1]); w.y = pk2(v[2], v[3]); w.z = pk2(v[4], v[5]); w.w = pk2(v[6], v[7]);
            *(u32x4*)(dst + (size_t)(drow0 + n) * K + k0 + k8) = w; } }
        __syncthreads();
    }
}
__device__ void prep_hid(PP p) {
    const int lane = otid() & 63, gw = blockIdx.x * 8 + (otid() >> 6), nw = gridDim.x * 8;
    float* HID = (float*)(p->ws + WS_HIDF);
    for (int item = gw; item < 2 * 2304; item += nw) {
        const int l = item / 2304, r = item % 2304; int n, i; if (r < 2048) { n = 2048; i = r; } else { n = 256; i = r - 2048; }
        const float ti = (float)i / (float)(n - 1), wi = (6.283185307179586f / (float)n) * (float)i;
        const float* w1 = p->hy_filt_w1 + (size_t)l * 33 * 64;
        float acc = p->hy_filt_b1[l * 64 + lane] + ti * w1[lane];
        for (int m = 0; m < 16; ++m) { const float fm = 1e-4f + (float)m * ((15.f - 1e-4f) / 15.f); float s, c; sincosf(fm * wi, &s, &c);
            acc += c * w1[(1 + m) * 64 + lane] - s * w1[(17 + m) * 64 + lane]; }
        const float h1 = sinf(p->hy_freq[(l * 2 + 0) * 64 + lane] * acc);
        const float* w2 = p->hy_filt_w2 + (size_t)l * 64 * 64;
        float acc2 = p->hy_filt_b2[l * 64 + lane];
        for (int jj = 0; jj < 64; ++jj) acc2 += __shfl(h1, jj) * w2[jj * 64 + lane];
        HID[((size_t)l * 2304 + r) * 64 + lane] = sinf(p->hy_freq[(l * 2 + 1) * 64 + lane] * acc2);
    }
}
__device__ void prep_mods(PP p, unsigned char* smem) {
    float* s = (float*)smem; float* part = s + 9 * 1024; float* MODS = (float*)(p->ws + WS_MODS);
    const int tid = otid();
    for (int bi = blockIdx.x; bi < 192; bi += gridDim.x) {
        __syncthreads();
        for (int e = tid; e < 9 * 1024; e += 512) { const int j = e >> 10, d = e & 1023; const float cv = (j < 8) ? p->c[j * 1024 + d] : p->c_ctx[d]; s[e] = cv / (1.f + expf(-cv)); }
        __syncthreads();
        const int l = bi / 96, e0 = (bi % 96) * 64, ec = tid & 63, ds = tid >> 6;
        float acc[9];
#pragma unroll
        for (int j = 0; j < 9; ++j) acc[j] = 0.f;
        const float* w = p->ada_w + ((size_t)l * 1024 + ds * 128) * 6144 + e0 + ec;
#pragma unroll 16
        for (int d = 0; d < 128; ++d) { const float wv = w[(size_t)d * 6144];
#pragma unroll
            for (int j = 0; j < 9; ++j) acc[j] += s[j * 1024 + ds * 128 + d] * wv; }
#pragma unroll
        for (int j = 0; j < 9; ++j) part[(ds * 9 + j) * 64 + ec] = acc[j];
        __syncthreads();
        for (int o = tid; o < 576; o += 512) { const int j = o >> 6, e2 = o & 63; float sum = 0.f;
            for (int d2 = 0; d2 < 8; ++d2) sum += part[(d2 * 9 + j) * 64 + e2];
            MODS[((size_t)l * 9 + j) * 6144 + e0 + e2] = sum + p->ada_b[l * 6144 + e0 + e2]; }
    }
    __syncthreads();
}

__device__ void phase_norm(PP p, int l, int which, const float* xl, const float* xc) {
    const int lane = otid() & 63, gw = blockIdx.x * 8 + (otid() >> 6), nw = gridDim.x * 8;
    const float* g = (which ? p->norm2_g : p->norm1_g) + l * 1024;
    const int shoff = which ? 3072 : 0, scoff = which ? 4096 : 1024;
    const float* MODS = (const float*)(p->ws + WS_MODS);
    bf16_t* H = (bf16_t*)(p->ws + WS_H);
    for (int r = gw; r < T; r += nw) {
        const int b = r / RPB, pp = r % RPB;
        if (which && l && pp < 256) continue;
        const float* src = pp < 256 ? xc + ((size_t)b * 256 + pp) * 1024 : xl + ((size_t)b * 2048 + (pp - 256)) * 1024;
        const float* md = MODS + ((size_t)l * 9 + (pp < 256 ? 8 : b)) * 6144;
        float4 v[4]; float ss = 0.f;
#pragma unroll
        for (int i = 0; i < 4; ++i) { v[i] = *(const float4*)(src + i * 256 + lane * 4); ss += v[i].x * v[i].x + v[i].y * v[i].y + v[i].z * v[i].z + v[i].w * v[i].w; }
        ss = wave_sum(ss); const float rstd = 1.0f / sqrtf(ss * (1.f / 1024.f) + 1e-6f);
#pragma unroll
        for (int i = 0; i < 4; ++i) { const int col = i * 256 + lane * 4;
            const float4 gg = *(const float4*)(g + col), sc = *(const float4*)(md + scoff + col), sh = *(const float4*)(md + shoff + col);
            u32x2 w; w.x = pk2(v[i].x * rstd * gg.x * (1.f + sc.x) + sh.x, v[i].y * rstd * gg.y * (1.f + sc.y) + sh.y);
            w.y = pk2(v[i].z * rstd * gg.z * (1.f + sc.z) + sh.z, v[i].w * rstd * gg.w * (1.f + sc.w) + sh.w);
            *(u32x2*)(H + (size_t)r * 1024 + col) = w; }
    }
}
__device__ void phase_qkprep(PP p, int l, unsigned char* smem) {
    float2* cs = (float2*)smem;
    const int tid = otid(), lane = tid & 63, gw = blockIdx.x * 8 + (tid >> 6), nw = gridDim.x * 8;
    __syncthreads();
    for (int e = tid; e < 2048; e += 512) { const int pos = e >> 5, fi = e & 31; float sn, c; sincosf((float)pos * powf(10000.f, -(float)fi / 32.f), &sn, &c); cs[e] = make_float2(c, sn); }
    __syncthreads();
    bf16_t* QKV = (bf16_t*)(p->ws + WS_QKV);
    const int j = lane & 15;
    float gq[8], gk[8];
#pragma unroll
    for (int e = 0; e < 8; ++e) { gq[e] = p->q_norm_g[l * 128 + 8 * j + e]; gk[e] = p->k_norm_g[l * 128 + 8 * j + e]; }
    const float sgn = (j & 4) ? 1.f : -1.f;
    for (int r = gw; r < T; r += nw) {
        const int pp = r % RPB; const bool lat = pp >= 256; const int t = pp - 256;
        const int pos = (j < 8) ? (t >> 6) : (t & 63);
        bf16_t* rowp = QKV + (size_t)r * 1536 + lane * 8;
        u32x4 raw[3];
        raw[0] = *(const u32x4*)(rowp); raw[1] = *(const u32x4*)(rowp + 512); raw[2] = (lane < 32) ? *(const u32x4*)(rowp + 1024) : (u32x4){0u, 0u, 0u, 0u};
#pragma unroll
        for (int g = 0; g < 3; ++g) {
            float x[8];
#pragma unroll
            for (int e = 0; e < 4; ++e) { x[2 * e] = __uint_as_float(raw[g][e] << 16); x[2 * e + 1] = __uint_as_float(raw[g][e] & 0xffff0000u); }
            float ss = 0.f;
#pragma unroll
            for (int e = 0; e < 8; ++e) ss += x[e] * x[e];
            ss += __shfl_xor(ss, 1); ss += __shfl_xor(ss, 2); ss += __shfl_xor(ss, 4); ss += __shfl_xor(ss, 8);
            const float rstd = 1.0f / sqrtf(ss * (1.f / 128.f) + 1e-6f);
#pragma unroll
            for (int e = 0; e < 8; ++e) x[e] = x[e] * rstd * (g < 2 ? gq[e] : gk[e]);
            if (lat) {
#pragma unroll
                for (int e = 0; e < 8; ++e) { const float pr = __shfl_xor(x[e], 4); const float2 c2 = cs[pos * 32 + 8 * (j & 3) + e]; x[e] = x[e] * c2.x + sgn * pr * c2.y; }
            }
            u32x4 w; w.x = pk2(x[0], x[1]); w.y = pk2(x[2], x[3]); w.z = pk2(x[4], x[5]); w.w = pk2(x[6], x[7]);
            if (g < 2 || lane < 32) *(u32x4*)(rowp + g * 512) = w;
        }
    }
    __syncthreads();
}
__device__ void phase_readout(PP p, int l, int hh) {
    const int tid = otid(), lane = tid & 63, gw = blockIdx.x * 8 + (tid >> 6), nw = gridDim.x * 8, j = lane & 15;
    const bf16_t* ZH = (const bf16_t*)(p->ws + WS_ZH); const bf16_t* OFB = (const bf16_t*)(p->ws + WS_OFB); bf16_t* HG = (bf16_t*)(p->ws + WS_HG);
    float gn[8];
#pragma unroll
    for (int e = 0; e < 8; ++e) gn[e] = p->hg_norm_g[l * 128 + 8 * j + e];
    for (int r = gw; r < T; r += nw) {
        if (l && (r % RPB) < 256) continue;
        const u32x4 a = *(const u32x4*)(OFB + (size_t)r * 512 + lane * 8), b = *(const u32x4*)(OFB + ((size_t)T + r) * 512 + lane * 8);
        const u32x4 gg = *(const u32x4*)(ZH + (size_t)r * 2560 + 2048 + lane * 8);
        float o[8], g[8];
#pragma unroll
        for (int e = 0; e < 4; ++e) { o[2 * e] = __uint_as_float(a[e] << 16) + __uint_as_float(b[e] << 16); o[2 * e + 1] = __uint_as_float(a[e] & 0xffff0000u) + __uint_as_float(b[e] & 0xffff0000u);
            g[2 * e] = __uint_as_float(gg[e] << 16); g[2 * e + 1] = __uint_as_float(gg[e] & 0xffff0000u); }
        {
          const int pp = r % RPB, bb = r / RPB, hl = lane >> 4; const bf16_t* OC = (const bf16_t*)(p->ws + WS_QS);
          if (pp >= 1152) { const u32x4 cf = *(const u32x4*)(OC + ((size_t)(((bb * 4 + hl) * 2 + 0) * 1152 + (pp - 1152))) * 128 + 8 * j);
#pragma unroll
              for (int e = 0; e < 4; ++e) { o[2 * e] += __uint_as_float(cf[e] << 16); o[2 * e + 1] += __uint_as_float(cf[e] & 0xffff0000u); } }
          if (pp >= 256 && pp <= 1407) { const u32x4 cb = *(const u32x4*)(OC + ((size_t)(((bb * 4 + hl) * 2 + 1) * 1152 + (1407 - pp))) * 128 + 8 * j);
#pragma unroll
              for (int e = 0; e < 4; ++e) { o[2 * e] += __uint_as_float(cb[e] << 16); o[2 * e + 1] += __uint_as_float(cb[e] & 0xffff0000u); } } }
        float ss = 0.f;
#pragma unroll
        for (int e = 0; e < 8; ++e) ss += o[e] * o[e];
        ss += __shfl_xor(ss, 1); ss += __shfl_xor(ss, 2); ss += __shfl_xor(ss, 4); ss += __shfl_xor(ss, 8);
        const float rstd = 1.0f / sqrtf(ss * (1.f / 128.f) + 1e-6f);
#pragma unroll
        for (int e = 0; e < 8; ++e) o[e] = o[e] * rstd * gn[e] * (g[e] * __builtin_amdgcn_rcpf(1.f + __expf(-g[e])));
        u32x4 w; w.x = pk2(o[0], o[1]); w.y = pk2(o[2], o[3]); w.z = pk2(o[4], o[5]); w.w = pk2(o[6], o[7]);
        *(u32x4*)(HG + (size_t)r * 1024 + hh * 512 + lane * 8) = w;
    }
}
__device__ void phase_transpose(PP p, unsigned char* smem) {
    bf16_t* tile = (bf16_t*)smem;
    const bf16_t* HYT = (const bf16_t*)(p->ws + WS_UT); bf16_t* HY = (bf16_t*)(p->ws + WS_HY);
    const int tid = otid();
    for (int g = blockIdx.x; g < (T / 128) * 16; g += gridDim.x) {
        const int t0 = (g >> 4) * 128, c0 = (g & 15) * 64;
        { const int cr = tid >> 3, t8 = (tid & 7) * 8; const bf16_t* src = HYT + (size_t)(c0 + cr) * T + t0 + t8;
          const u32x4 a = *(const u32x4*)(src), b = *(const u32x4*)(src + 64);
          *(u32x4*)(tile + cr * 136 + t8) = a; *(u32x4*)(tile + cr * 136 + t8 + 64) = b; }
        __syncthreads();
        { const int tr = tid >> 2, cq = (tid & 3) * 16; bf16_t v[16];
#pragma unroll
          for (int i = 0; i < 16; ++i) v[i] = tile[(cq + i) * 136 + tr];
          u32x4 w0, w1; w0.x = v[0] | ((unsigned)v[1] << 16); w0.y = v[2] | ((unsigned)v[3] << 16); w0.z = v[4] | ((unsigned)v[5] << 16); w0.w = v[6] | ((unsigned)v[7] << 16);
          w1.x = v[8] | ((unsigned)v[9] << 16); w1.y = v[10] | ((unsigned)v[11] << 16); w1.z = v[12] | ((unsigned)v[13] << 16); w1.w = v[14] | ((unsigned)v[15] << 16);
          bf16_t* dst = HY + (size_t)(t0 + tr) * 1024 + c0 + cq; *(u32x4*)(dst) = w0; *(u32x4*)(dst + 8) = w1; }
        __syncthreads();
    }
}

__device__ void phase_attn(PP p, int l, unsigned char* smem) {
    const att::bf16* QKV = (const att::bf16*)(p->ws + WS_QKV); bf16_t* ATT = (bf16_t*)(p->ws + WS_ATT);
    const int nitems = 512 + (l == 0 ? 64 : 0);
    for (int it = blockIdx.x; it < nitems; it += gridDim.x) {
        int b, h, seq; size_t r0;
        if (it < 512) {
            const int xr = it & 255, rd = it >> 8, pair = rd * 8 + (xr & 7), j = xr >> 3;
            b = pair >> 1; h = (pair & 1) * 4 + (j >> 3); r0 = (size_t)b * RPB + 256 + (size_t)(j & 7) * 256; seq = RPB; }
        else { const int q = it - 512; b = q >> 3; h = q & 7; r0 = (size_t)b * RPB; seq = 256; }
        __syncthreads();
        const att::bf16* Kp = QKV + (size_t)b * RPB * 1536 + 1024 + (h >> 2) * 128;
        att::attn_dense_body<att::bf16>(QKV + r0 * 1536 + h * 128, Kp, Kp + 256, ATT + r0 * 1024 + h * 128, seq, (char*)smem);
    }
    __syncthreads();
}

#define MFMA16(a, b, c) __builtin_amdgcn_mfma_f32_16x16x32_bf16(a, b, c, 0, 0, 0)
#define SCAN_START(cc) (dir == 0 ? 64 * (cc) : ((cc) < 4 ? 255 - 64 * (cc) : 256 + 2047 - 64 * ((cc) - 4)))
__device__ void phase_scan(PP p, int l, int hh, unsigned char* smem) {
    bf16_t* Qhat = (bf16_t*)smem;
    bf16_t* Qtil = Qhat + 64 * 136;
    bf16_t* Khat = Qtil + 64 * 136;
    bf16_t* KtT  = Khat + 160 * 136;
    bf16_t* Vt   = KtT + 128 * 72;
    bf16_t* Pm   = Vt + 64 * 72;
    bf16_t* St   = Pm + 64 * 72;
    float* segsum = (float*)(St + 64 * 136);
    float* dvec = segsum + 1024;
    const bf16_t* ZH = (const bf16_t*)(p->ws + WS_ZH); bf16_t* OFB = (bf16_t*)(p->ws + WS_OFB);
    const int tid = otid(), lane = tid & 63, wid = __builtin_amdgcn_readfirstlane(tid >> 6), li = lane & 15, lg = lane >> 4;
    const int kp = lane, sg8 = wid, Iown = wid >> 1;
    for (int item = blockIdx.x; item < 256; item += gridDim.x) {
        const int sj = item & 1, vh = (item >> 1) & 1, dir = (item >> 2) & 1, hl = (item >> 3) & 3, b = item >> 5, h = hh * 4 + hl, grp = item >> 2;
        float lb[2] = {0.f, 0.f};
        if (l > 0) {
#pragma unroll
            for (int c = 0; c < 2; ++c) { const float r0 = p->hg_lb_raw[(0 * 2 + dir) * 1024 + h * 128 + 2 * kp + c], r1 = p->hg_lb_raw[(1 * 2 + dir) * 1024 + h * 128 + 2 * kp + c];
                const float mx = fmaxf(r0, r1), e0 = expf(r0 - mx), e1 = expf(r1 - mx); const float s0 = e0 / (e0 + e1), s1 = e1 / (e0 + e1); lb[c] = (s0 + s1) - s0; } }
        const float oml[2] = {1.f - lb[0], 1.f - lb[1]};
        __syncthreads();
        for (int e = tid; e < 64 * 136; e += 512) St[e] = 0;
        for (int e = tid; e < 64 * 72; e += 512) Pm[e] = 0;
        f32x4 sacc[4] = {{0.f, 0.f, 0.f, 0.f}, {0.f, 0.f, 0.f, 0.f}, {0.f, 0.f, 0.f, 0.f}, {0.f, 0.f, 0.f, 0.f}};
        unsigned zr[8], qr[8]; u32x4 vr = {0u, 0u, 0u, 0u};
        float runseg[2] = {0.f, 0.f};
        const size_t rb = (size_t)b * RPB;
        const int zcol = (1 + dir) * 512 + hl * 128 + 2 * kp, qcol = hl * 128 + 2 * kp, vcol = 3 * 512 + hl * 128 + vh * 64 + (tid & 7) * 8;
        const int sgn = dir ? -1 : 1, cbeg = 18 * sj;
        bf16_t* QSg = (bf16_t*)(p->ws + WS_QS) + (size_t)grp * 1152 * 128;
#define SCAN_LOAD(cc) do { const int st_ = SCAN_START(cc); \
        _Pragma("unroll") for (int r = 0; r < 8; ++r) { const size_t row_ = rb + (size_t)(st_ + sgn * (sg8 * 8 + r)); zr[r] = *(const unsigned*)(ZH + row_ * 2560 + zcol); qr[r] = *(const unsigned*)(ZH + row_ * 2560 + qcol); } \
        { const size_t row_ = rb + (size_t)(st_ + sgn * (tid >> 3)); vr = *(const u32x4*)(ZH + row_ * 2560 + vcol); } } while (0)
        SCAN_LOAD(cbeg);
        for (int c = cbeg; c < cbeg + 18; ++c) {
            const int start = SCAN_START(c);
            float cum[8][2], kk[8][2], qv[8][2]; float run0 = 0.f, run1 = 0.f;
#pragma unroll
            for (int r = 0; r < 8; ++r) {
#pragma unroll
                for (int cc = 0; cc < 2; ++cc) { const float zz = __uint_as_float(cc ? (zr[r] & 0xffff0000u) : (zr[r] << 16));
                    const float z = fminf(fmaxf(zz, -30.f), 30.f); const float ez = __expf(-z), sg = __builtin_amdgcn_rcpf(1.f + ez), sgm = ez * sg;
                    const float f = lb[cc] + oml[cc] * sg, lf = __builtin_amdgcn_logf(fmaxf(f, 1e-6f));
                    if (cc) { run1 += lf; cum[r][1] = run1; } else { run0 += lf; cum[r][0] = run0; }
                    kk[r][cc] = oml[cc] * sgm; qv[r][cc] = __uint_as_float(cc ? (qr[r] & 0xffff0000u) : (qr[r] << 16)); } }
            *(float2*)(segsum + sg8 * 128 + 2 * kp) = make_float2(run0, run1);
            const u32x4 vcur = vr;
            __syncthreads();
            if (c + 1 < cbeg + 18) SCAN_LOAD(c + 1);
            float pre0[9], pre1[9]; pre0[0] = 0.f; pre1[0] = 0.f;
#pragma unroll
            for (int j = 0; j < 8; ++j) { const float2 sj2 = *(const float2*)(segsum + j * 128 + 2 * kp); pre0[j + 1] = pre0[j] + sj2.x; pre1[j + 1] = pre1[j] + sj2.y; }
            float myc0[2], mys[2], lastv[2], e1[2], e2[2], e3[2], eseg[2], eqs[2];
            myc0[0] = Iown == 0 ? 0.f : (Iown == 1 ? pre0[2] : (Iown == 2 ? pre0[4] : pre0[6])); myc0[1] = Iown == 0 ? 0.f : (Iown == 1 ? pre1[2] : (Iown == 2 ? pre1[4] : pre1[6]));
            { float a0 = pre0[0], a1 = pre1[0];
#pragma unroll
              for (int j = 1; j < 8; ++j) { if (sg8 == j) { a0 = pre0[j]; a1 = pre1[j]; } }
              mys[0] = a0; mys[1] = a1; }
            lastv[0] = pre0[8]; lastv[1] = pre1[8];
            e1[0] = __builtin_amdgcn_exp2f(pre0[2] - myc0[0]); e1[1] = __builtin_amdgcn_exp2f(pre1[2] - myc0[1]); e2[0] = __builtin_amdgcn_exp2f(pre0[4] - myc0[0]); e2[1] = __builtin_amdgcn_exp2f(pre1[4] - myc0[1]);
            e3[0] = __builtin_amdgcn_exp2f(pre0[6] - myc0[0]); e3[1] = __builtin_amdgcn_exp2f(pre1[6] - myc0[1]); eseg[0] = __builtin_amdgcn_exp2f(myc0[0]); eseg[1] = __builtin_amdgcn_exp2f(myc0[1]);
            eqs[0] = eseg[0] * __builtin_amdgcn_exp2f(runseg[0]); eqs[1] = eseg[1] * __builtin_amdgcn_exp2f(runseg[1]);
            const float elast[2] = {__builtin_amdgcn_exp2f(lastv[0] - myc0[0]), __builtin_amdgcn_exp2f(lastv[1] - myc0[1])};
            const bool wqs = (sj == 1) && (vh == 0);
            unsigned ktp[2][4];
#pragma unroll
            for (int r = 0; r < 8; ++r) { const int t = sg8 * 8 + r;
                float qh[2], kb[2], kt[2];
#pragma unroll
                for (int cc = 0; cc < 2; ++cc) { const float ca = mys[cc] + cum[r][cc], clb = ca - myc0[cc];
                    qh[cc] = qv[r][cc] * __builtin_amdgcn_exp2f(clb); kb[cc] = kk[r][cc] * __builtin_amdgcn_exp2f(fminf(-clb, 86.f)); kt[cc] = kb[cc] * elast[cc]; }
                *(unsigned*)(Qhat + t * 136 + 2 * kp) = pk2(qh[0], qh[1]);
                *(unsigned*)(Qtil + t * 136 + 2 * kp) = pk2(qh[0] * eseg[0], qh[1] * eseg[1]);
                if (wqs) *(unsigned*)(QSg + ((size_t)(c - 18) * 64 + t) * 128 + 2 * kp) = pk2(qh[0] * eqs[0], qh[1] * eqs[1]);
                if (Iown == 0) *(unsigned*)(Khat + (0 + t) * 136 + 2 * kp)  = pk2(kb[0], kb[1]);
                if (Iown <= 1) *(unsigned*)(Khat + (16 + t) * 136 + 2 * kp) = (Iown == 1) ? pk2(kb[0], kb[1]) : pk2(kb[0] * e1[0], kb[1] * e1[1]);
                if (Iown <= 2) *(unsigned*)(Khat + (48 + t) * 136 + 2 * kp) = (Iown == 2) ? pk2(kb[0], kb[1]) : pk2(kb[0] * e2[0], kb[1] * e2[1]);
                *(unsigned*)(Khat + (96 + t) * 136 + 2 * kp) = (Iown == 3) ? pk2(kb[0], kb[1]) : pk2(kb[0] * e3[0], kb[1] * e3[1]);
                const unsigned k0b = f2bf(kt[0]), k1b = f2bf(kt[1]);
                if (r & 1) { ktp[0][r >> 1] |= k0b << 16; ktp[1][r >> 1] |= k1b << 16; } else { ktp[0][r >> 1] = k0b; ktp[1][r >> 1] = k1b; } }
            runseg[0] += lastv[0]; runseg[1] += lastv[1];
#pragma unroll
            for (int cc = 0; cc < 2; ++cc) { u32x4 w0 = {ktp[cc][0], ktp[cc][1], ktp[cc][2], ktp[cc][3]}; *(u32x4*)(KtT + (2 * kp + cc) * 72 + sg8 * 8) = w0; }
            if (sg8 == 0) *(float2*)(dvec + 2 * kp) = make_float2(__builtin_amdgcn_exp2f(lastv[0]), __builtin_amdgcn_exp2f(lastv[1]));
            { const int s = tid >> 3, v8 = (tid & 7) * 8;
#pragma unroll
              for (int j = 0; j < 4; ++j) { Vt[(v8 + 2 * j) * 72 + s] = (bf16_t)(vcur[j] & 0xffffu); Vt[(v8 + 2 * j + 1) * 72 + s] = (bf16_t)(vcur[j] >> 16); } }
            __syncthreads();
            for (int idx = wid; idx < 10; idx += 8) {
                const int I = idx >= 6 ? 3 : (idx >= 3 ? 2 : (idx >= 1 ? 1 : 0)), J = idx - I * (I + 1) / 2, koff = I == 0 ? 0 : (I == 1 ? 16 : (I == 2 ? 48 : 96));
                f32x4 acc = {0.f, 0.f, 0.f, 0.f};
#pragma unroll
                for (int ks = 0; ks < 4; ++ks) { const bf16x8 a = *(const bf16x8*)(Qhat + (16 * I + li) * 136 + ks * 32 + lg * 8);
                    const bf16x8 bb = *(const bf16x8*)(Khat + (koff + 16 * J + li) * 136 + ks * 32 + lg * 8); acc = MFMA16(a, bb, acc); }
#pragma unroll
                for (int r = 0; r < 4; ++r) { const int tl = 4 * lg + r; float v = acc[r]; if (I == J && li > tl) v = 0.f; Pm[(16 * I + tl) * 72 + 16 * J + li] = f2bf_sw(v); }
            }
            __syncthreads();
            { const int tI = wid >> 1;
              bf16x8 aq[4], ap[2];
#pragma unroll
              for (int ks = 0; ks < 4; ++ks) aq[ks] = *(const bf16x8*)(Qtil + (16 * tI + li) * 136 + ks * 32 + lg * 8);
#pragma unroll
              for (int ks = 0; ks < 2; ++ks) ap[ks] = *(const bf16x8*)(Pm + (16 * tI + li) * 72 + ks * 32 + lg * 8);
#pragma unroll
              for (int jv = 0; jv < 2; ++jv) { const int vJ = 2 * (wid & 1) + jv; f32x4 acc = {0.f, 0.f, 0.f, 0.f};
#pragma unroll
                  for (int ks = 0; ks < 4; ++ks) { const bf16x8 bb = *(const bf16x8*)(St + (16 * vJ + li) * 136 + ks * 32 + lg * 8); acc = MFMA16(aq[ks], bb, acc); }
#pragma unroll
                  for (int ks = 0; ks < 2; ++ks) { const bf16x8 bb = *(const bf16x8*)(Vt + (16 * vJ + li) * 72 + ks * 32 + lg * 8); acc = MFMA16(ap[ks], bb, acc); }
#pragma unroll
                  for (int r = 0; r < 4; ++r) { const int t = 16 * tI + 4 * lg + r; const size_t row = rb + (size_t)(start + sgn * t);
                      OFB[((size_t)dir * T + row) * 512 + hl * 128 + vh * 64 + 16 * vJ + li] = f2bf_sw(acc[r]); } } }
            { const int vI = wid & 3;
              bf16x8 av[2];
#pragma unroll
              for (int ks = 0; ks < 2; ++ks) av[ks] = *(const bf16x8*)(Vt + (16 * vI + li) * 72 + ks * 32 + lg * 8);
#pragma unroll
              for (int jj = 0; jj < 4; ++jj) { const int kJ = (wid >> 2) * 4 + jj; const float dk = dvec[16 * kJ + li];
                  sacc[jj] = sacc[jj] * dk;
#pragma unroll
                  for (int ks = 0; ks < 2; ++ks) { const bf16x8 bb = *(const bf16x8*)(KtT + (16 * kJ + li) * 72 + ks * 32 + lg * 8); sacc[jj] = MFMA16(av[ks], bb, sacc[jj]); } } }
            __syncthreads();
            { const int vI = wid & 3;
#pragma unroll
              for (int jj = 0; jj < 4; ++jj) { const int kJ = (wid >> 2) * 4 + jj;
#pragma unroll
                  for (int r = 0; r < 4; ++r) St[(16 * vI + 4 * lg + r) * 136 + 16 * kJ + li] = f2bf_sw(sacc[jj][r]); } }
        }
        if (sj == 0) {
            float* S0 = (float*)(p->ws + WS_ST0) + ((size_t)grp * 2 + vh) * 64 * 128; const int vI = wid & 3;
#pragma unroll
            for (int jj = 0; jj < 4; ++jj) { const int kJ = (wid >> 2) * 4 + jj;
#pragma unroll
                for (int r = 0; r < 4; ++r) S0[(16 * vI + 4 * lg + r) * 128 + 16 * kJ + li] = sacc[jj][r]; }
        }
#undef SCAN_LOAD
    }
    __syncthreads();
}
__device__ void phase_scan_corr(PP p, unsigned char* smem) {
    bf16_t* Qs = (bf16_t*)smem;
    bf16_t* St = Qs + 64 * 136;
    const int tid = otid(), lane = tid & 63, wid = __builtin_amdgcn_readfirstlane(tid >> 6), li = lane & 15, lg = lane >> 4;
    for (int item = blockIdx.x; item < 256; item += gridDim.x) {
        const int part = item & 3, grp = item >> 2;
        const float* S0 = (const float*)(p->ws + WS_ST0) + (size_t)grp * 2 * 64 * 128;
        bf16_t* QSg = (bf16_t*)(p->ws + WS_QS) + (size_t)grp * 1152 * 128;
        __syncthreads();
#pragma unroll
        for (int j = 0; j < 2; ++j) { const int e = tid + 512 * j, v = e >> 3, k16 = (e & 7) * 16; const float4* sp = (const float4*)(S0 + v * 128 + k16);
          const float4 a = sp[0], b4 = sp[1], c4 = sp[2], d4 = sp[3];
          u32x4 w0 = {pk2(a.x, a.y), pk2(a.z, a.w), pk2(b4.x, b4.y), pk2(b4.z, b4.w)}, w1 = {pk2(c4.x, c4.y), pk2(c4.z, c4.w), pk2(d4.x, d4.y), pk2(d4.z, d4.w)};
          *(u32x4*)(St + v * 136 + k16) = w0; *(u32x4*)(St + v * 136 + k16 + 8) = w1; }
        for (int cl = (18 * part) >> 2; cl < (18 * (part + 1)) >> 2; ++cl) {
            __syncthreads();
#pragma unroll
            for (int j = 0; j < 2; ++j) { const int e = tid + 512 * j, row = e >> 4, c8 = (e & 15) * 8;
                *(u32x4*)(Qs + row * 136 + c8) = *(const u32x4*)(QSg + ((size_t)cl * 64 + row) * 128 + c8); }
            __syncthreads();
            const int tI = wid >> 1;
#pragma unroll
            for (int jv = 0; jv < 4; ++jv) { const int vJ = 4 * (wid & 1) + jv; f32x4 acc = {0.f, 0.f, 0.f, 0.f};
#pragma unroll
                for (int ks = 0; ks < 4; ++ks) { const bf16x8 a = *(const bf16x8*)(Qs + (16 * tI + li) * 136 + ks * 32 + lg * 8);
                    const bf16x8 bb = *(const bf16x8*)(St + (16 * vJ + li) * 136 + ks * 32 + lg * 8); acc = MFMA16(a, bb, acc); }
#pragma unroll
                for (int r = 0; r < 4; ++r) QSg[((size_t)cl * 64 + 16 * tI + 4 * lg + r) * 128 + 16 * vJ + li] = f2bf_sw(acc[r]); }
        }
    }
    __syncthreads();
}
#undef SCAN_START

__device__ __forceinline__ float2 cmul(float2 a, float2 b) { return make_float2(a.x * b.x - a.y * b.y, a.x * b.y + a.y * b.x); }
template <int M, bool INV>
__device__ __forceinline__ void fft_r4(float2*& x, float2*& y, const float2* tw, int nseq, int tid) {
    constexpr int NP = (M == 4096) ? 6 : 5, Q = M / 4, TS = 4096 / M;
#pragma unroll 1
    for (int ps = 0; ps < NP; ++ps) {
        const int sh = 2 * ps, s = 1 << sh, n1 = Q >> sh;
        for (int idx = tid; idx < nseq * Q; idx += 512) {
            const int sq = idx / Q, j = idx % Q, pq = j >> sh, q = j & (s - 1);
            float2 w1 = tw[(pq << sh) * TS]; if (INV) w1.y = -w1.y;
            const float2 w2 = cmul(w1, w1), w3 = cmul(w2, w1);
            const float2* xs = x + sq * M + q + s * pq; float2* ys = y + sq * M + q + s * 4 * pq;
            const float2 a = xs[0], b = xs[s * n1], c = xs[2 * s * n1], d = xs[3 * s * n1];
            const float2 apc = make_float2(a.x + c.x, a.y + c.y), amc = make_float2(a.x - c.x, a.y - c.y);
            const float2 bpd = make_float2(b.x + d.x, b.y + d.y), bmd = make_float2(b.x - d.x, b.y - d.y);
            const float2 jb = INV ? make_float2(bmd.y, -bmd.x) : make_float2(-bmd.y, bmd.x);
            ys[0] = make_float2(apc.x + bpd.x, apc.y + bpd.y);
            ys[s] = cmul(w1, make_float2(amc.x - jb.x, amc.y - jb.y));
            ys[2 * s] = cmul(w2, make_float2(apc.x - bpd.x, apc.y - bpd.y));
            ys[3 * s] = cmul(w3, make_float2(amc.x + jb.x, amc.y + jb.y));
        }
        __syncthreads();
        float2* t = x; x = y; y = t;
    }
}
constexpr float HY_MIN_DECAY_C = -3.0701134573253945f, HY_MAX_DECAY_C = -15.350567286626972f;

template <int N, int M>
__device__ __forceinline__ void hyena_filter(PP p, int l, int c, const float* hid, float2*& x, float2*& y, float2* Hs0, float2* Hs1, const float2* tw, float* w3s, float* red) {
    const int tid = otid(), lane = tid & 63, wid = tid >> 6;
    if (tid < 256) { const int q = tid >> 6, j = tid & 63; w3s[tid] = p->hy_filt_w3[((size_t)l * 64 + j) * 4096 + (q >> 1) * 2048 + (q & 1) * 1024 + c]; }
    for (int e = tid; e < M; e += 512) x[e] = make_float2(0.f, 0.f);
    __syncthreads();
    const float delta = fabsf(HY_MIN_DECAY_C + (float)c * ((HY_MAX_DECAY_C - HY_MIN_DECAY_C) / 1023.f));
    constexpr int NL = (N + 511) / 512;
    float as0 = 0.f, as1 = 0.f;
#pragma unroll 1
    for (int jl = 0; jl < NL; ++jl) { const int i = tid + 512 * jl;
        if (i < N) { const float ti = (float)i / (float)(N - 1), dec = __expf(-ti * delta); const float4* hr = (const float4*)(hid + (size_t)i * 64);
            float4 hv[16];
#pragma unroll
            for (int j = 0; j < 16; ++j) hv[j] = hr[j];
            float d0 = 0.f, d1 = 0.f, d2 = 0.f, d3 = 0.f;
#pragma unroll
            for (int j = 0; j < 16; ++j) {
                d0 += hv[j].x * w3s[4 * j] + hv[j].y * w3s[4 * j + 1] + hv[j].z * w3s[4 * j + 2] + hv[j].w * w3s[4 * j + 3];
                d1 += hv[j].x * w3s[64 + 4 * j] + hv[j].y * w3s[64 + 4 * j + 1] + hv[j].z * w3s[64 + 4 * j + 2] + hv[j].w * w3s[64 + 4 * j + 3];
                d2 += hv[j].x * w3s[128 + 4 * j] + hv[j].y * w3s[128 + 4 * j + 1] + hv[j].z * w3s[128 + 4 * j + 2] + hv[j].w * w3s[128 + 4 * j + 3];
                d3 += hv[j].x * w3s[192 + 4 * j] + hv[j].y * w3s[192 + 4 * j + 1] + hv[j].z * w3s[192 + 4 * j + 2] + hv[j].w * w3s[192 + 4 * j + 3]; }
            d0 *= dec; d1 *= dec; d2 *= dec; d3 *= dec;
            x[i] = make_float2(d0, d2); if (i >= 1) x[M - i] = make_float2(d1, d3);
            as0 += fabsf(d0) + (i >= 1 ? fabsf(d1) : 0.f); as1 += fabsf(d2) + (i >= 1 ? fabsf(d3) : 0.f); } }
    as0 = wave_sum(as0); as1 = wave_sum(as1);
    if (lane == 0) { red[wid * 2] = as0; red[wid * 2 + 1] = as1; }
    __syncthreads();
    float t0 = 0.f, t1 = 0.f;
#pragma unroll
    for (int w = 0; w < 8; ++w) { t0 += red[w * 2]; t1 += red[w * 2 + 1]; }
    const float sc0 = 1.f / (t0 + 1e-6f), sc1 = 1.f / (t1 + 1e-6f);
    for (int e = tid; e < M; e += 512) { const float2 v = x[e]; x[e] = make_float2(v.x * sc0, v.y * sc1); }
    __syncthreads();
    fft_r4<M, false>(x, y, tw, 1, tid);
    constexpr float HSC = 0.5f / (float)M;
    for (int kx = tid; kx < M; kx += 512) { const float2 zk = x[kx], zm = x[(M - kx) & (M - 1)];
        Hs0[kx] = make_float2(HSC * (zk.x + zm.x), HSC * (zk.y - zm.y));
        Hs1[kx] = make_float2(HSC * (zk.y + zm.y), -HSC * (zk.x - zm.x)); }
    __syncthreads();
}
template <int N, int M, int NSEQ>
__device__ __forceinline__ void hyena_seqs(PP p, int l, int c, int pair0, int tokoff, float2*& x, float2*& y, const float2* Hs0, const float2* Hs1, const float2* tw, bf16_t* UT) {
    const int tid = otid();
    constexpr int NE = N * NSEQ / 512;
    float sw[3][3], sb[3];
#pragma unroll
    for (int sec = 0; sec < 3; ++sec) { sb[sec] = p->hy_short_b[l * 3072 + sec * 1024 + c];
#pragma unroll
        for (int tap = 0; tap < 3; ++tap) sw[sec][tap] = p->hy_short_w[((size_t)l * 3 + tap) * 3072 + sec * 1024 + c]; }
    const float bias0 = p->hy_bias[(l * 2 + 0) * 1024 + c], bias1 = p->hy_bias[(l * 2 + 1) * 1024 + c];
#define HY_SCONV(sec, pr, t, out) do { const bf16_t* u0_ = UT + (size_t)((sec) * 1024 + c) * T + (size_t)(2 * (pr)) * RPB + tokoff; const bf16_t* u1_ = u0_ + RPB; \
        const float a0_ = (t) > 0 ? bf2f(u0_[(t) - 1]) : 0.f, a1_ = bf2f(u0_[(t)]), a2_ = (t) < N - 1 ? bf2f(u0_[(t) + 1]) : 0.f; \
        const float b0_ = (t) > 0 ? bf2f(u1_[(t) - 1]) : 0.f, b1_ = bf2f(u1_[(t)]), b2_ = (t) < N - 1 ? bf2f(u1_[(t) + 1]) : 0.f; \
        out = make_float2(a0_ * sw[sec][0] + a1_ * sw[sec][1] + a2_ * sw[sec][2] + sb[sec], b0_ * sw[sec][0] + b1_ * sw[sec][1] + b2_ * sw[sec][2] + sb[sec]); } while (0)
    float2 vz[NE], z1[NE];
#pragma unroll
    for (int j = 0; j < NE; ++j) { const int e = tid + 512 * j, pl = e / N, t = e % N; HY_SCONV(2, pair0 + pl, t, vz[j]); x[pl * M + t] = vz[j]; }
    for (int e = tid; e < NSEQ * (M - N); e += 512) { const int pl = e / (M - N), t = N + e % (M - N); x[pl * M + t] = make_float2(0.f, 0.f); }
    __syncthreads();
    fft_r4<M, false>(x, y, tw, NSEQ, tid);
    for (int e = tid; e < NSEQ * M; e += 512) x[e] = cmul(x[e], Hs0[e & (M - 1)]);
    __syncthreads();
    fft_r4<M, true>(x, y, tw, NSEQ, tid);
#pragma unroll
    for (int j = 0; j < NE; ++j) { const int e = tid + 512 * j, pl = e / N, t = e % N; const float2 zc = x[pl * M + t]; float2 x1; HY_SCONV(0, pair0 + pl, t, x1);
        z1[j] = make_float2(x1.x * (zc.x + vz[j].x * bias0), x1.y * (zc.y + vz[j].y * bias0)); }
    __syncthreads();
#pragma unroll
    for (int j = 0; j < NE; ++j) { const int e = tid + 512 * j, pl = e / N, t = e % N; x[pl * M + t] = z1[j]; }
    for (int e = tid; e < NSEQ * (M - N); e += 512) { const int pl = e / (M - N), t = N + e % (M - N); x[pl * M + t] = make_float2(0.f, 0.f); }
    __syncthreads();
    fft_r4<M, false>(x, y, tw, NSEQ, tid);
    for (int e = tid; e < NSEQ * M; e += 512) x[e] = cmul(x[e], Hs1[e & (M - 1)]);
    __syncthreads();
    fft_r4<M, true>(x, y, tw, NSEQ, tid);
#pragma unroll
    for (int j = 0; j < NE; ++j) { const int e = tid + 512 * j, pl = e / N, t = e % N; const float2 zc = x[pl * M + t]; float2 x2; HY_SCONV(1, pair0 + pl, t, x2);
        bf16_t* o0 = UT + (size_t)c * T + (size_t)(2 * (pair0 + pl)) * RPB + tokoff + t;
        o0[0] = f2bf(x2.x * (zc.x + z1[j].x * bias1)); o0[RPB] = f2bf(x2.y * (zc.y + z1[j].y * bias1)); }
    __syncthreads();
#undef HY_SCONV
}
template <bool INV>
__device__ __forceinline__ void r4bf(float2& a, float2& b, float2& c, float2& d, float2 w1, float2 w2, float2 w3) {
    const float2 apc = make_float2(a.x + c.x, a.y + c.y), amc = make_float2(a.x - c.x, a.y - c.y);
    const float2 bpd = make_float2(b.x + d.x, b.y + d.y), bmd = make_float2(b.x - d.x, b.y - d.y);
    const float2 jb = INV ? make_float2(bmd.y, -bmd.x) : make_float2(-bmd.y, bmd.x);
    a = make_float2(apc.x + bpd.x, apc.y + bpd.y);
    b = cmul(w1, make_float2(amc.x - jb.x, amc.y - jb.y));
    c = cmul(w2, make_float2(apc.x - bpd.x, apc.y - bpd.y));
    d = cmul(w3, make_float2(amc.x + jb.x, amc.y + jb.y));
}
template <bool INV, bool WONE = false>
__device__ __forceinline__ void r16bf(float2 (&v)[16], float2 W) {
    constexpr float C16[10] = {1.f, 0.92387953251128674f, 0.70710678118654752f, 0.38268343236508977f, 0.f, -0.38268343236508977f, -0.70710678118654752f, -0.92387953251128674f, -1.f, -0.92387953251128674f};
    constexpr float S16[10] = {0.f, 0.38268343236508977f, 0.70710678118654752f, 0.92387953251128674f, 1.f, 0.92387953251128674f, 0.70710678118654752f, 0.38268343236508977f, 0.f, -0.38268343236508977f};
    if (WONE) W = make_float2(1.f, 0.f);
    if (INV) W.y = -W.y;
    const float2 W2 = cmul(W, W), W3 = cmul(W2, W), W4 = cmul(W2, W2), W8 = cmul(W4, W4), W12 = cmul(W8, W4);
#pragma unroll
    for (int mp = 0; mp < 4; ++mp) {
        const float2 o1 = make_float2(C16[mp], INV ? S16[mp] : -S16[mp]), o2 = make_float2(C16[2 * mp], INV ? S16[2 * mp] : -S16[2 * mp]), o3 = make_float2(C16[3 * mp], INV ? S16[3 * mp] : -S16[3 * mp]);
        r4bf<INV>(v[mp], v[mp + 4], v[mp + 8], v[mp + 12], cmul(W, o1), cmul(W2, o2), cmul(W3, o3));
    }
    float2 t[16];
#pragma unroll
    for (int m = 0; m < 4; ++m) { float2 a = v[4 * m], b = v[4 * m + 1], c = v[4 * m + 2], d = v[4 * m + 3]; r4bf<INV>(a, b, c, d, W4, W8, W12); t[m] = a; t[m + 4] = b; t[m + 8] = c; t[m + 12] = d; }
#pragma unroll
    for (int o = 0; o < 16; ++o) v[o] = t[o];
}
constexpr int HSEQ = 4352;
template <bool INV>
__device__ __forceinline__ void fft4096_tail(float2 (&v)[16], float2* xb, const float2* tw, int u, bool active) {
    if (active) {
#pragma unroll
        for (int o = 0; o < 16; ++o) xb[17 * u + o] = v[o]; }
    __syncthreads();
    if (active) {
#pragma unroll
        for (int r = 0; r < 16; ++r) v[r] = xb[u + 256 * r + (u >> 4) + 16 * r]; }
    __syncthreads();
    if (active) { r16bf<INV>(v, tw[u & ~15]);
        const int q = u & 15, pp = u >> 4;
#pragma unroll
        for (int o = 0; o < 16; ++o) xb[q + 256 * pp + 16 * o] = v[o]; }
    __syncthreads();
    if (active) {
#pragma unroll
        for (int r = 0; r < 16; ++r) v[r] = xb[u + 256 * r]; }
    __syncthreads();
    if (active) r16bf<INV>(v, tw[0]);
}
__device__ __forceinline__ void hyena_lat2(PP p, int l, int c, int pair0, float2* buf, const float2* Hs0, const float2* Hs1, const float2* tw, bf16_t* UT) {
    const int tid = otid(), sq = tid >> 8, u = tid & 255, pair = pair0 + sq;
    float2* xb = buf + sq * HSEQ;
    float sw[3][3], sb[3];
#pragma unroll
    for (int sec = 0; sec < 3; ++sec) { sb[sec] = p->hy_short_b[l * 3072 + sec * 1024 + c];
#pragma unroll
        for (int tap = 0; tap < 3; ++tap) sw[sec][tap] = p->hy_short_w[((size_t)l * 3 + tap) * 3072 + sec * 1024 + c]; }
    const float bias0 = p->hy_bias[(l * 2 + 0) * 1024 + c], bias1 = p->hy_bias[(l * 2 + 1) * 1024 + c];
#define HY_SCONV2(sec, t, out) do { const bf16_t* u0_ = UT + (size_t)((sec) * 1024 + c) * T + (size_t)(2 * pair) * RPB + 256; const bf16_t* u1_ = u0_ + RPB; \
        const float a0_ = (t) > 0 ? bf2f(u0_[(t) - 1]) : 0.f, a1_ = bf2f(u0_[(t)]), a2_ = (t) < 2047 ? bf2f(u0_[(t) + 1]) : 0.f; \
        const float b0_ = (t) > 0 ? bf2f(u1_[(t) - 1]) : 0.f, b1_ = bf2f(u1_[(t)]), b2_ = (t) < 2047 ? bf2f(u1_[(t) + 1]) : 0.f; \
        out = make_float2(a0_ * sw[sec][0] + a1_ * sw[sec][1] + a2_ * sw[sec][2] + sb[sec], b0_ * sw[sec][0] + b1_ * sw[sec][1] + b2_ * sw[sec][2] + sb[sec]); } while (0)
    float2 v[16], vz[8], z1[8], x1c[8], x2c[8];
#pragma unroll
    for (int r = 0; r < 8; ++r) { HY_SCONV2(2, u + 256 * r, vz[r]); v[r] = vz[r]; v[8 + r] = make_float2(0.f, 0.f); }
#pragma unroll
    for (int r = 0; r < 8; ++r) { HY_SCONV2(0, u + 256 * r, x1c[r]); }
#pragma unroll
    for (int r = 0; r < 8; ++r) { HY_SCONV2(1, u + 256 * r, x2c[r]); }
    r16bf<false>(v, tw[u]); fft4096_tail<false>(v, xb, tw, u, true);
#pragma unroll
    for (int o = 0; o < 16; ++o) v[o] = cmul(v[o], Hs0[u + 256 * o]);
    r16bf<true>(v, tw[u]); fft4096_tail<true>(v, xb, tw, u, true);
#pragma unroll
    for (int r = 0; r < 8; ++r) { const float2 x1 = x1c[r]; z1[r] = make_float2(x1.x * (v[r].x + vz[r].x * bias0), x1.y * (v[r].y + vz[r].y * bias0)); v[r] = z1[r]; }
#pragma unroll
    for (int r = 8; r < 16; ++r) v[r] = make_float2(0.f, 0.f);
    __syncthreads();
    r16bf<false>(v, tw[u]); fft4096_tail<false>(v, xb, tw, u, true);
#pragma unroll
    for (int o = 0; o < 16; ++o) v[o] = cmul(v[o], Hs1[u + 256 * o]);
    r16bf<true>(v, tw[u]); fft4096_tail<true>(v, xb, tw, u, true);
#pragma unroll
    for (int r = 0; r < 8; ++r) { const float2 x2 = x2c[r];
        bf16_t* o0 = UT + (size_t)c * T + (size_t)(2 * pair) * RPB + 256 + u + 256 * r;
        o0[0] = f2bf(x2.x * (v[r].x + z1[r].x * bias1)); o0[RPB] = f2bf(x2.y * (v[r].y + z1[r].y * bias1)); }
    __syncthreads();
#undef HY_SCONV2
}
__device__ __forceinline__ void hyena_filter_lat(PP p, int l, int c, const float* hid, float2* buf, float2* Hs0, float2* Hs1, const float2* tw, float* w3s, float* red) {
    constexpr int N = 2048, M = 4096;
    const int tid = otid(), lane = tid & 63, wid = tid >> 6;
    float2* x = buf;
    if (tid < 256) { const int q = tid >> 6, j = tid & 63; w3s[tid] = p->hy_filt_w3[((size_t)l * 64 + j) * 4096 + (q >> 1) * 2048 + (q & 1) * 1024 + c]; }
    for (int e = tid; e < M; e += 512) x[e] = make_float2(0.f, 0.f);
    __syncthreads();
    const float delta = fabsf(HY_MIN_DECAY_C + (float)c * ((HY_MAX_DECAY_C - HY_MIN_DECAY_C) / 1023.f));
    float as0 = 0.f, as1 = 0.f;
#pragma unroll 1
    for (int jl = 0; jl < 4; ++jl) { const int i = tid + 512 * jl;
        const float ti = (float)i / (float)(N - 1), dec = __expf(-ti * delta); const float4* hr = (const float4*)(hid + (size_t)i * 64);
        float4 hv[16];
#pragma unroll
        for (int j = 0; j < 16; ++j) hv[j] = hr[j];
        float d0 = 0.f, d1 = 0.f, d2 = 0.f, d3 = 0.f;
#pragma unroll
        for (int j = 0; j < 16; ++j) {
            d0 += hv[j].x * w3s[4 * j] + hv[j].y * w3s[4 * j + 1] + hv[j].z * w3s[4 * j + 2] + hv[j].w * w3s[4 * j + 3];
            d1 += hv[j].x * w3s[64 + 4 * j] + hv[j].y * w3s[64 + 4 * j + 1] + hv[j].z * w3s[64 + 4 * j + 2] + hv[j].w * w3s[64 + 4 * j + 3];
            d2 += hv[j].x * w3s[128 + 4 * j] + hv[j].y * w3s[128 + 4 * j + 1] + hv[j].z * w3s[128 + 4 * j + 2] + hv[j].w * w3s[128 + 4 * j + 3];
            d3 += hv[j].x * w3s[192 + 4 * j] + hv[j].y * w3s[192 + 4 * j + 1] + hv[j].z * w3s[192 + 4 * j + 2] + hv[j].w * w3s[192 + 4 * j + 3]; }
        d0 *= dec; d1 *= dec; d2 *= dec; d3 *= dec;
        x[i] = make_float2(d0, d2); if (i >= 1) x[M - i] = make_float2(d1, d3);
        as0 += fabsf(d0) + (i >= 1 ? fabsf(d1) : 0.f); as1 += fabsf(d2) + (i >= 1 ? fabsf(d3) : 0.f); }
    as0 = wave_sum(as0); as1 = wave_sum(as1);
    if (lane == 0) { red[wid * 2] = as0; red[wid * 2 + 1] = as1; }
    __syncthreads();
    float t0 = 0.f, t1 = 0.f;
#pragma unroll
    for (int w = 0; w < 8; ++w) { t0 += red[w * 2]; t1 += red[w * 2 + 1]; }
    const float sc0 = 1.f / (t0 + 1e-6f), sc1 = 1.f / (t1 + 1e-6f);
    const bool active = tid < 256; const int u = tid & 255;
    float2 v[16];
    if (active) {
#pragma unroll
        for (int r = 0; r < 16; ++r) { const float2 a = x[u + 256 * r]; v[r] = make_float2(a.x * sc0, a.y * sc1); } }
    __syncthreads();
    if (active) r16bf<false>(v, tw[u]);
    fft4096_tail<false>(v, x, tw, u, active);
    constexpr float HSC = 0.5f / (float)M;
    if (active) {
#pragma unroll
        for (int o = 0; o < 16; ++o) x[u + 256 * o] = v[o]; }
    __syncthreads();
    for (int kx = tid; kx < M; kx += 512) { const float2 zk = x[kx], zm = x[(M - kx) & (M - 1)];
        Hs0[kx] = make_float2(HSC * (zk.x + zm.x), HSC * (zk.y - zm.y));
        Hs1[kx] = make_float2(HSC * (zk.y + zm.y), -HSC * (zk.x - zm.x)); }
    __syncthreads();
}
__device__ void phase_hyena(PP p, int l, unsigned char* smem) {
    float2* buf = (float2*)smem; float2* Hs0 = buf + 2 * HSEQ; float2* Hs1 = Hs0 + 4096; float2* tw = Hs1 + 4096;
    float* w3s = (float*)(tw + 1024); float* red = w3s + 256;
    const int tid = otid();
    bf16_t* UT = (bf16_t*)(p->ws + WS_UT);
    const float* HID = (const float*)(p->ws + WS_HIDF) + (size_t)l * 2304 * 64;
    __syncthreads();
    for (int e = tid; e < 1024; e += 512) { float s, c; sincospif((float)e / 2048.f, &s, &c); tw[e] = make_float2(c, -s); }
    __syncthreads();
    for (int c = blockIdx.x; c < 1024; c += gridDim.x) {
        hyena_filter_lat(p, l, c, HID, buf, Hs0, Hs1, tw, w3s, red);
        hyena_lat2(p, l, c, 0, buf, Hs0, Hs1, tw, UT);
        hyena_lat2(p, l, c, 2, buf, Hs0, Hs1, tw, UT);
        if (l == 0) {
            float2* x = buf; float2* y = buf + 4096;
            hyena_filter<256, 1024>(p, l, c, HID + (size_t)2048 * 64, x, y, Hs0, Hs1, tw, w3s, red);
            hyena_seqs<256, 1024, 4>(p, l, c, 0, 0, x, y, Hs0, Hs1, tw, UT);
        }
    }
    __syncthreads();
}

constexpr int PH_PER_LAYER = 20, N_PHASES = 1 + 2 * PH_PER_LAYER;
__device__ __forceinline__ void run_phase(PP p, int ph, unsigned char* smem) {
#ifndef NO_PH0
    if (ph == 0) { conv_weights(p, 0, smem, 0, 6272, 0); prep_hid(p); prep_mods(p, smem);
        { const size_t gt = (size_t)blockIdx.x * 512 + otid(), gs = (size_t)gridDim.x * 512; float4* XC4 = (float4*)(p->ws + WS_XC);
          for (size_t i = gt; i < (size_t)8 * 2048 * 1024 / 4; i += gs) ((float4*)p->out)[i] = ((const float4*)p->x)[i];
          for (size_t i = gt; i < (size_t)8 * 256 * 1024 / 4; i += gs) XC4[i] = ((const float4*)p->ctx)[i]; }
        return; }
#endif
    const int l = (ph - 1) / PH_PER_LAYER, ik = (ph - 1) % PH_PER_LAYER;
    const int k = ik < 6 ? ik : (ik == 6 ? 18 : (ik < 10 ? ik - 1 : (ik == 10 ? 19 : ik - 2)));
#ifndef PH_MASK
#define PH_MASK 0xfffff
#endif
#define ON(kk) (((PH_MASK) >> (kk)) & 1)
    const float* xl_in = p->out; const float* xc_in = (const float*)(p->ws + WS_XC);
    float* XC = (float*)(p->ws + WS_XC);
    const bf16_t* H = (const bf16_t*)(p->ws + WS_H); const bf16_t* WIN = (const bf16_t*)(p->ws + WS_WIN);
    const float* mods_l = (const float*)(p->ws + WS_MODS) + (size_t)l * 9 * 6144;
    if (ON(0) && k == 0) { if (l > 0) conv_weights(p, l, smem, 5248, 6272, 0); phase_norm(p, l, 0, xl_in, xc_in); }
    else if (ON(1) && (k == 1 || k == 4 || k == 7 || k == 10)) {
        const bf16_t* A = H; const bf16_t* Bt = WIN; int nM = 72, nN = 6; EpiBf<0> E{(bf16_t*)(p->ws + WS_QKV), 1536};
        if (k == 4 || k == 7) { Bt = WIN + (size_t)(1536 + (k == 7 ? 2560 : 0)) * 1024; nN = 10; E.O = (bf16_t*)(p->ws + WS_ZH); E.ldc = 2560; }
        if (k == 10) { A = WIN + (size_t)6656 * 1024; Bt = H; nM = 12; nN = 72; E.O = (bf16_t*)(p->ws + WS_UT); E.ldc = T; }
        int skp = 0; if (k == 10 && l == 1) { nN = 64; skp = 2; }
        run_gemm(smem, A, Bt, nM, nN, 1024, 0, skp, E);
    }
    else if (ON(2) && k == 2) phase_qkprep(p, l, smem);
    else if (ON(3) && k == 3) phase_attn(p, l, smem);
    else if (ON(5) && (k == 5 || k == 8)) phase_scan(p, l, k == 8 ? 1 : 0, smem);
    else if (ON(18) && (k == 18 || k == 19)) phase_scan_corr(p, smem);
    else if (ON(6) && (k == 6 || k == 9)) phase_readout(p, l, k == 9 ? 1 : 0);
    else if (ON(11) && k == 11) phase_hyena(p, l, smem);
    else if (ON(12) && k == 12) phase_transpose(p, smem);
    else if (ON(13) && k == 13) {
#pragma unroll 1
        for (int i = 0; i < 3; ++i) {
            EpiBf<1> Eg{(bf16_t*)(p->ws + WS_G), 1024};
            run_gemm(smem, H, WIN + (size_t)(9728 + i * 1024) * 1024, l ? 64 : 72, 4, 1024, 0, l, Eg);
            const bf16_t* A = (const bf16_t*)(p->ws + (i == 0 ? WS_ATT : (i == 1 ? WS_HG : WS_HY)));
            EpiMerge Em{(const bf16_t*)(p->ws + WS_G), (bf16_t*)(p->ws + WS_MRG), i == 0 ? 1 : 0};
            run_gemm(smem, A, (const bf16_t*)(p->ws + WS_WBR) + (size_t)i * 1024 * 1024, l ? 64 : 72, 4, 1024, 0, l, Em);
        }
    }
    else if (ON(14) && (k == 14 || k == 17)) {
        EpiResid E{p->out, XC, mods_l, k == 14 ? 2048 : 5120};
        const bf16_t* A = (const bf16_t*)(p->ws + (k == 14 ? WS_MRG : WS_HID4)); const bf16_t* Bt = (const bf16_t*)(p->ws + (k == 14 ? WS_WOUT : WS_WM2));
        run_gemm(smem, A, Bt, l ? 64 : 72, 4, k == 14 ? 1024 : 4096, 0, l, E);
        if (l == 0) { if (k == 14) conv_weights(p, 1, smem, 0, 3968, 32); else conv_weights(p, 1, smem, 4224, 5248, 32); }
    }
    else if (ON(15) && k == 15) { if (l == 0) conv_weights(p, 1, smem, 3968, 4224, 0); phase_norm(p, l, 1, p->out, XC); }
    else if (ON(16) && k == 16) { EpiBf<2> E{(bf16_t*)(p->ws + WS_HID4), 4096}; run_gemm(smem, H, (const bf16_t*)(p->ws + WS_WM1), l ? 64 : 72, 16, 1024, 0, l, E); }
}

__global__ void __launch_bounds__(512, 2) hybrid_flow_megakernel(Params p, int ph_lo, int ph_hi) {
    extern __shared__ __attribute__((aligned(16))) unsigned char smem[];
    cg::grid_group grid = cg::this_grid();
    volatile LAS unsigned* bst = (volatile LAS unsigned*)(smem + LDS_BYTES - 16);
    if (threadIdx.x < 4) bst[threadIdx.x] = 0u;
    __syncthreads();
    XcdBarrier bar = xcd_barrier_post((unsigned*)(p.ws + WS_CTL), bst);
#ifdef PROBE_MASK
    const int n_extra = PROBE_REP * __builtin_popcount(PROBE_MASK);
#else
    const int n_extra = 0;
#endif
    for (int it = ph_lo; it < ph_hi + n_extra; ++it) {
        int ph = it;
#ifdef PROBE_MASK
        if (it >= ph_hi) { int j = (it - ph_hi) % __builtin_popcount(PROBE_MASK), k = 0; for (;; ++k) if ((PROBE_MASK >> k) & 1) { if (j == 0) break; --j; } ph = 1 + PH_PER_LAYER + k; }
#endif
        PP pp = (PP)__builtin_amdgcn_kernarg_segment_ptr();
        asm volatile("" : "+s"(pp));
        run_phase(pp, ph, smem);
        if (it + 1 < ph_hi + n_extra) { if (ph_hi > (1 << 20)) grid.sync(); xcd_barrier(bar); }
    }
}

#ifndef N_LAUNCH_SPLIT
#define N_LAUNCH_SPLIT 0
#endif
extern "C" void kernel_launch(void* const* d_in, const int* in_sizes, int n_in, void* d_out, int out_size, void* d_ws, size_t ws_size, hipStream_t stream) {
    static int grid_blocks = 0;
    if (grid_blocks == 0) {
        if (n_in != 26 || ws_size < WS_END) { fprintf(stderr, "kernel_launch: n_in %d ws %zu need %zu\n", n_in, ws_size, (size_t)WS_END); grid_blocks = -1; return; }
        int dev = 0, cus = 0, per_cu = 0;
        hipGetDevice(&dev); hipDeviceGetAttribute(&cus, hipDeviceAttributeMultiprocessorCount, dev);
        if (hipFuncSetAttribute((const void*)hybrid_flow_megakernel, hipFuncAttributeMaxDynamicSharedMemorySize, LDS_BYTES) != hipSuccess) { fprintf(stderr, "kernel_launch: LDS attribute failed\n"); grid_blocks = -1; return; }
        if (hipOccupancyMaxActiveBlocksPerMultiprocessor(&per_cu, (const void*)hybrid_flow_megakernel, 512, LDS_BYTES) != hipSuccess || per_cu < 1) { fprintf(stderr, "kernel_launch: occupancy query failed (%d)\n", per_cu); grid_blocks = -1; return; }
        grid_blocks = cus * 1;
    }
    if (grid_blocks < 0) return;
    Params p{};
    const float** pp = (const float**)&p;
    for (int i = 0; i < 26; ++i) pp[i] = (const float*)d_in[i];
    p.out = (float*)d_out; p.ws = (unsigned char*)d_ws;
#if N_LAUNCH_SPLIT
    for (int ph = 0; ph < N_PHASES; ++ph) { int lo = ph, hi = ph + 1; void* args[] = {&p, &lo, &hi};
        hipLaunchCooperativeKernel((const void*)hybrid_flow_megakernel, dim3(grid_blocks), dim3(512), args, LDS_BYTES, stream); }
#else
    if (hipMemsetAsync((unsigned char*)d_ws + WS_CTL, 0, 16384, stream) != hipSuccess) { fprintf(stderr, "kernel_launch: memset failed\n"); return; }
    int lo = 0, hi = N_PHASES; void* args[] = {&p, &lo, &hi};
    hipError_t e = hipLaunchCooperativeKernel((const void*)hybrid_flow_megakernel, dim3(grid_blocks), dim3(512), args, LDS_BYTES, stream);
    if (e != hipSuccess) fprintf(stderr, "cooperative launch failed: %s (grid %d)\n", hipGetErrorString(e), grid_blocks);
#endif
}
```
